# Optimizing an MI355X kernel written in HIP

```python
import jax, jax.numpy as jnp
from jax import lax
import numpy as np

D_MODEL = 1024
BATCH = 16
SEQ = 2048
DEPTH = 1

GRID_W = 64
CTX_LEN = 256
POOL_WIDTH = 512
POOL_WINDOWS = (2, 4, 8, 16)
POOL_GROUPS = len(POOL_WINDOWS)
POOL_GROUP_DIM = POOL_WIDTH // POOL_GROUPS
MLSTM_HEADS = 4
QK_HEAD_DIM = 64
V_HEAD_DIM = 128
QK_WIDTH = MLSTM_HEADS * QK_HEAD_DIM
MLSTM_WIDTH = MLSTM_HEADS * V_HEAD_DIM
N_GATES = 4 * MLSTM_HEADS
MIX_WIDTH = POOL_WIDTH + MLSTM_WIDTH
IN_WIDTH = POOL_WIDTH + 2 * QK_WIDTH + 2 * MLSTM_WIDTH + N_GATES
CONV_W = 3
CHUNK = 64
D_FF = -(-8 * D_MODEL // (3 * 256)) * 256
EPS = 1e-6

kernel_name = 'hybrid_pool_mlstm_dit_block'


def rmsnorm(x, g):
    xf = x.astype(jnp.float32)
    y = xf * lax.rsqrt(jnp.mean(xf * xf, axis=-1, keepdims=True) + EPS)
    return (y * g.astype(jnp.float32)).astype(x.dtype)


def modulate(h, shift, scale):
    return h * (1 + scale) + shift


def short_conv(u, w):
    pad = CONV_W // 2
    t = u.shape[1]
    up = jnp.pad(u, ((0, 0), (pad, pad), (0, 0)))
    return sum(w[j] * up[:, j:j + t] for j in range(CONV_W))


def pool_mixer(u, pool_w, pool_scale):
    length = u.shape[-2]
    pos = jnp.arange(length)
    uf = u.astype(jnp.float32)
    cs = jnp.cumsum(uf, axis=-2)
    cs = jnp.concatenate([jnp.zeros_like(cs[..., :1, :]), cs], axis=-2)
    outs = []
    for gi, win in enumerate(POOL_WINDOWS):
        lo = jnp.clip(pos - win // 2, 0, length - 1)
        hi = jnp.clip(pos + win // 2 - 1, 0, length - 1)
        sl = slice(gi * POOL_GROUP_DIM, (gi + 1) * POOL_GROUP_DIM)
        csg = cs[..., sl]
        s = jnp.take(csg, hi + 1, axis=-2) - jnp.take(csg, lo, axis=-2)
        cnt = (hi - lo + 1).astype(jnp.float32)[:, None]
        d = (s / cnt - uf[..., sl]).astype(u.dtype)
        outs.append(jnp.einsum('...lc,cd->...ld', d, pool_w[gi]))
    return jnp.concatenate(outs, axis=-1) * pool_scale


def mlstm_chunk_scan(q, k, v, i_pre, logf, state):
    bsz, nh, t, _ = q.shape
    dv = v.shape[-1]
    nc = t // CHUNK
    mask = jnp.tril(jnp.ones((CHUNK, CHUNK), dtype=bool))

    def to_chunks(a):
        a = a.reshape(a.shape[:2] + (nc, CHUNK) + a.shape[3:])
        return jnp.moveaxis(a, 2, 0)

    def step(carry, xs):
        c0, n0, m0 = carry
        qc, kc, vc, ic, fc = xs
        b = jnp.cumsum(fc, axis=-1)
        dmat = jnp.where(mask, b[..., :, None] - b[..., None, :] + ic[..., None, :], -jnp.inf)
        inter = b + m0[..., None]
        m = jnp.maximum(inter, jnp.max(dmat, axis=-1))
        s = jnp.einsum('bhjd,bhsd->bhjs', qc, kc) * jnp.exp(dmat - m[..., None])
        w_inter = jnp.exp(inter - m)
        num = jnp.einsum('bhjs,bhsv->bhjv', s, vc) + w_inter[..., None] * jnp.einsum('bhvd,bhjd->bhjv', c0, qc)
        den = jnp.sum(s, axis=-1) + w_inter * jnp.einsum('bhd,bhjd->bhj', n0, qc)
        h = num / jnp.maximum(jnp.abs(den), jnp.exp(-m))[..., None]
        bl = b[..., -1]
        wk = bl[..., None] - b + ic
        m_new = jnp.maximum(bl + m0, jnp.max(wk, axis=-1))
        decay = jnp.exp(bl + m0 - m_new)
        wk = jnp.exp(wk - m_new[..., None])
        c_new = decay[..., None, None] * c0 + jnp.einsum('bhs,bhsv,bhsd->bhvd', wk, vc, kc)
        n_new = decay[..., None] * n0 + jnp.einsum('bhs,bhsd->bhd', wk, kc)
        return (c_new, n_new, m_new), h

    xs = (to_chunks(q), to_chunks(k), to_chunks(v), to_chunks(i_pre), to_chunks(logf))
    state, hs = lax.scan(step, state, xs)
    hs = jnp.moveaxis(hs, 0, 2).reshape(bsz, nh, t, dv)
    return hs, state


def zero_state(bsz):
    return (jnp.zeros((bsz, MLSTM_HEADS, V_HEAD_DIM, QK_HEAD_DIM), jnp.float32),
            jnp.zeros((bsz, MLSTM_HEADS, QK_HEAD_DIM), jnp.float32),
            jnp.zeros((bsz, MLSTM_HEADS), jnp.float32))


def mlstm_bidir(q, k, v, gates, st_f, st_b):
    bsz, t, _ = gates.shape
    g = jnp.transpose(gates.astype(jnp.float32).reshape(bsz, t, 4, MLSTM_HEADS), (2, 0, 3, 1))
    i_f, i_b = g[0], g[1]
    lf_f, lf_b = jax.nn.log_sigmoid(g[2]), jax.nn.log_sigmoid(g[3])
    h_f, st_f = mlstm_chunk_scan(q, k, v, i_f, lf_f, st_f)
    fl = lambda a: jnp.flip(a, axis=2)
    h_b, st_b = mlstm_chunk_scan(fl(q), fl(k), fl(v), fl(i_b), fl(lf_b), st_b)
    return h_f + fl(h_b), st_f, st_b


def heads(a, d):
    bsz, t, _ = a.shape
    return jnp.transpose(a.reshape(bsz, t, MLSTM_HEADS, d), (0, 2, 1, 3)).astype(jnp.float32)


def project(h, w_in, conv_qk, gate_bias):
    p = h @ w_in
    o1 = POOL_WIDTH
    o2 = o1 + 2 * QK_WIDTH
    o3 = o2 + MLSTM_WIDTH
    o4 = o3 + MLSTM_WIDTH
    pool_in = p[..., :o1]
    qk = jax.nn.silu(short_conv(p[..., o1:o2], conv_qk))
    q = heads(qk[..., :QK_WIDTH], QK_HEAD_DIM) * (QK_HEAD_DIM ** -0.5)
    k = heads(qk[..., QK_WIDTH:], QK_HEAD_DIM)
    v = heads(p[..., o2:o3], V_HEAD_DIM)
    o = p[..., o3:o4]
    gates = p[..., o4:] + gate_bias
    return pool_in, q, k, v, o, gates


def mlstm_output(hm, o, head_norm):
    hn = hm * lax.rsqrt(jnp.mean(hm * hm, axis=-1, keepdims=True) + EPS)
    bsz, _, t, _ = hm.shape
    hn = jnp.transpose(hn, (0, 2, 1, 3)).reshape(bsz, t, MLSTM_WIDTH).astype(o.dtype)
    return hn * head_norm * jax.nn.sigmoid(o)


def swiglu(h, w_up, w_down):
    u = h @ w_up
    g, a = jnp.split(u, 2, axis=-1)
    return (jax.nn.silu(g) * a) @ w_down


def setup_inputs(seed: int = 0) -> dict:
    key = jax.random.key(seed)
    ks = jax.random.split(key, 20)
    f32 = jnp.float32
    nrm = lambda k, shape, s: jax.random.normal(k, shape, f32) * s
    gate_i = nrm(ks[7], (DEPTH, 2 * MLSTM_HEADS), 0.1)
    gate_f = 3.0 + 3.0 * jax.random.uniform(ks[8], (DEPTH, 2 * MLSTM_HEADS), f32)
    return {
        'x': nrm(ks[0], (BATCH, SEQ, D_MODEL), 1.0),
        'c': nrm(ks[1], (BATCH, D_MODEL), 1.0),
        'ctx': nrm(ks[2], (BATCH, CTX_LEN, D_MODEL), 1.0),
        'c_ctx': nrm(ks[3], (D_MODEL,), 1.0),
        'w_ada': nrm(ks[4], (DEPTH, D_MODEL, 6 * D_MODEL), D_MODEL ** -0.5),
        'b_ada': nrm(ks[5], (DEPTH, 6 * D_MODEL), 0.02),
        'norm1': 1.0 + nrm(ks[6], (DEPTH, D_MODEL), 0.02),
        'w_in': nrm(ks[9], (DEPTH, D_MODEL, IN_WIDTH), D_MODEL ** -0.5),
        'conv_qk': nrm(ks[10], (DEPTH, CONV_W, 2 * QK_WIDTH), CONV_W ** -0.5),
        'gate_bias': jnp.concatenate([gate_i, gate_f], axis=-1),
        'pool_w': nrm(ks[11], (DEPTH, POOL_GROUPS, POOL_GROUP_DIM, POOL_GROUP_DIM), POOL_GROUP_DIM ** -0.5),
        'pool_scale': 1.0 + nrm(ks[12], (DEPTH, POOL_WIDTH), 0.02),
        'head_norm': 1.0 + nrm(ks[13], (DEPTH, MLSTM_WIDTH), 0.02),
        'w_out': nrm(ks[14], (DEPTH, MIX_WIDTH, D_MODEL), MIX_WIDTH ** -0.5),
        'norm2': 1.0 + nrm(ks[15], (DEPTH, D_MODEL), 0.02),
        'w_up': nrm(ks[16], (DEPTH, D_MODEL, 2 * D_FF), D_MODEL ** -0.5),
        'w_down': nrm(ks[17], (DEPTH, D_FF, D_MODEL), D_FF ** -0.5),
        'norm_f': 1.0 + nrm(ks[18], (D_MODEL,), 0.02),
    }


def reference(x, c, ctx, c_ctx, w_ada, b_ada, norm1, w_in, conv_qk, gate_bias, pool_w,
              pool_scale, head_norm, w_out, norm2, w_up, w_down, norm_f):
    bsz, t, _ = x.shape
    rows = t // GRID_W
    xc = ctx
    for l in range(DEPTH):
        last = l == DEPTH - 1
        mod = (jax.nn.silu(c) @ w_ada[l] + b_ada[l])[:, None, :]
        sh1, sc1, g1, sh2, sc2, g2 = jnp.split(mod, 6, axis=-1)
        mod_c = jax.nn.silu(c_ctx) @ w_ada[l] + b_ada[l]
        csh1, csc1, cg1, csh2, csc2, cg2 = jnp.split(mod_c, 6, axis=-1)

        hx = modulate(rmsnorm(x, norm1[l]), sh1, sc1)
        hc = modulate(rmsnorm(xc, norm1[l]), csh1, csc1)
        px, qx, kx, vx, ox, gx = project(hx, w_in[l], conv_qk[l], gate_bias[l])
        pc, qc, kc, vc, oc, gc = project(hc, w_in[l], conv_qk[l], gate_bias[l])

        hc_m, st_f, st_b = mlstm_bidir(qc, kc, vc, gc, zero_state(bsz), zero_state(bsz))
        hx_m, _, _ = mlstm_bidir(qx, kx, vx, gx, st_f, st_b)

        pool_x = pool_mixer(px.reshape(bsz, rows, GRID_W, POOL_WIDTH), pool_w[l], pool_scale[l])
        pool_x = pool_x.reshape(bsz, t, POOL_WIDTH)
        mix_x = jnp.concatenate([pool_x, mlstm_output(hx_m, ox, head_norm[l])], axis=-1) @ w_out[l]
        x = x + g1 * mix_x
        x = x + g2 * swiglu(modulate(rmsnorm(x, norm2[l]), sh2, sc2), w_up[l], w_down[l])

        if not last:
            pool_c = pool_mixer(pc, pool_w[l], pool_scale[l])
            mix_c = jnp.concatenate([pool_c, mlstm_output(hc_m, oc, head_norm[l])], axis=-1) @ w_out[l]
            xc = xc + cg1 * mix_c
            xc = xc + cg2 * swiglu(modulate(rmsnorm(xc, norm2[l]), csh2, csc2), w_up[l], w_down[l])
    return rmsnorm(x, norm_f)
```

```cpp
#include <hip/hip_runtime.h>
#include <hip/hip_cooperative_groups.h>
#include <cstdio>
#include <cstdint>
namespace cg = cooperative_groups;
namespace pg8 {
#define PG8_LAS __attribute__((address_space(3)))
typedef unsigned short bf16_t;
typedef short bf16x8 __attribute__((ext_vector_type(8)));
typedef float f32x4 __attribute__((ext_vector_type(4)));
typedef unsigned u32x4 __attribute__((ext_vector_type(4)));
constexpr int BM = 256, BK = 64, HALF = 128, HTB = HALF * BK * 2  , STAGE_BYTES = 8 * HTB, NXCD = 8, WGM = 8;

__host__ __device__ __forceinline__ int lds_byte(int r, int c) { const int st = (r >> 4) * 2 + (c >> 5), rr = r & 15, cc = c & 31, ob = rr * 64 + cc * 2; return st * 1024 + (ob ^ (((ob >> 9) & 1) << 5)); }
__host__ __device__ __forceinline__ void stage_rc(int b, int& R, int& C) { const int st = b / 1024, sb = b % 1024, swz = sb ^ (((sb >> 9) & 1) << 5); R = (st >> 1) * 16 + swz / 64; C = (st & 1) * 32 + (swz % 64) / 2; }
__host__ __device__ __forceinline__ int perm32(int rho) { const int n = rho >> 4, i = rho & 15; return 8 * (i >> 2) + 4 * n + (i & 3); }

struct Unit { int pm, pn; };
struct Gemm { const bf16_t* A; const bf16_t* Bt; int M, N, K; };

struct StaticOrder {
    int nM, nN, nwg, G, c;
    __host__ __device__ void init(int M, int N, int G_, int c_) { nM = M / BM; nN = N / BM; nwg = nM * nN; G = G_; c = c_; }
    __host__ __device__ bool next(int i, Unit& u) const {
        const long L = (long)i * G + c; if (L >= nwg) return false;
        int wgid = (int)L; { const int q = nwg / NXCD, r = nwg % NXCD, xcd = wgid % NXCD, off = wgid / NXCD; wgid = (xcd < r ? xcd * (q + 1) : r * (q + 1) + (xcd - r) * q) + off; }
        const int nig = WGM * nN, gid = wgid / nig, fm = gid * WGM, gsz = (nM - fm) < WGM ? (nM - fm) : WGM;
        u.pm = fm + ((wgid % nig) % gsz); u.pn = (wgid % nig) / gsz; return true;
    }
    __device__ __forceinline__ void a_ready(const Unit&) const {}
    __device__ __forceinline__ void done(const Unit&) const {}
};


typedef float f32x2 __attribute__((ext_vector_type(2)));
typedef __bf16 bf16x2_t __attribute__((ext_vector_type(2)));
__device__ __forceinline__ unsigned cvt_pk_bf16(float lo, float hi) { f32x2 v = {lo, hi}; bf16x2_t b = __builtin_convertvector(v, bf16x2_t); return __builtin_bit_cast(unsigned, b); }

struct EpiBf16Plain {
    static constexpr bool PERM = true, AFTER_DRAIN = false;
    bf16_t* O; int ldc;
    __device__ __forceinline__ void operator()(const f32x4 (&acc)[2][2][4][2], const Unit& u, int wr, int wc, int fr, int fq) const {
        const int row0 = u.pm * BM + wr * 64 + fr; const int col0 = u.pn * BM + wc * 32 + 8 * fq;
#pragma unroll
        for (int ai = 0; ai < 2; ++ai)
#pragma unroll
            for (int m = 0; m < 4; ++m) { bf16_t* rowp = O + (size_t)(row0 + ai * HALF + m * 16) * ldc + col0;
#pragma unroll
                for (int bj = 0; bj < 2; ++bj) { const f32x4 v0 = acc[ai][bj][m][0], v1 = acc[ai][bj][m][1];
                    u32x4 w; w.x = cvt_pk_bf16(v0[0], v0[1]); w.y = cvt_pk_bf16(v0[2], v0[3]); w.z = cvt_pk_bf16(v1[0], v1[1]); w.w = cvt_pk_bf16(v1[2], v1[3]);
                    *(u32x4*)(rowp + bj * HALF) = w; } }
    }
};
struct EpiResGate {
    static constexpr bool PERM = false, AFTER_DRAIN = false;
    const float* base; float* out; int ldc; const float* gate; int gate_stride; int tiles_per_batch;
    __device__ __forceinline__ void operator()(const f32x4 (&acc)[2][2][4][2], const Unit& u, int wr, int wc, int fr, int fq) const {
        const int row0 = u.pm * BM + wr * 64 + fr, col0 = u.pn * BM + wc * 32 + 4 * fq;
        const float* gp = gate + (size_t)(u.pm / tiles_per_batch) * gate_stride + col0;
        f32x4 gv[2][2];
#pragma unroll
        for (int bj = 0; bj < 2; ++bj)
#pragma unroll
            for (int n = 0; n < 2; ++n) gv[bj][n] = *(const f32x4*)(gp + bj * HALF + n * 16);
#pragma unroll
        for (int ai = 0; ai < 2; ++ai)
#pragma unroll
            for (int m = 0; m < 4; ++m) { const size_t off = (size_t)(row0 + ai * HALF + m * 16) * ldc + col0;
#pragma unroll
                for (int bj = 0; bj < 2; ++bj)
#pragma unroll
                    for (int n = 0; n < 2; ++n) { const f32x4 bs = *(const f32x4*)(base + off + bj * HALF + n * 16);
                        *(f32x4*)(out + off + bj * HALF + n * 16) = bs + gv[bj][n] * acc[ai][bj][m][n]; } }
    }
};
__device__ __forceinline__ float silu_f(float g) { return g * __builtin_amdgcn_rcpf(1.0f + __builtin_amdgcn_exp2f(-1.4426950408889634f * g)); }
struct EpiSwiglu {
    static constexpr bool PERM = true, AFTER_DRAIN = false;
    bf16_t* O; int ldc;
    __device__ __forceinline__ void operator()(const f32x4 (&acc)[2][2][4][2], const Unit& u, int wr, int wc, int fr, int fq) const {
        const int row0 = u.pm * BM + wr * 64 + fr; const int col0 = u.pn * HALF + wc * 32 + 8 * fq;
#pragma unroll
        for (int ai = 0; ai < 2; ++ai)
#pragma unroll
            for (int m = 0; m < 4; ++m) { bf16_t* rowp = O + (size_t)(row0 + ai * HALF + m * 16) * ldc + col0;
                const f32x4 g0 = acc[ai][0][m][0], g1 = acc[ai][0][m][1], a0 = acc[ai][1][m][0], a1 = acc[ai][1][m][1];
                u32x4 w;
                w.x = cvt_pk_bf16(silu_f(g0[0]) * a0[0], silu_f(g0[1]) * a0[1]); w.y = cvt_pk_bf16(silu_f(g0[2]) * a0[2], silu_f(g0[3]) * a0[3]);
                w.z = cvt_pk_bf16(silu_f(g1[0]) * a1[0], silu_f(g1[1]) * a1[1]); w.w = cvt_pk_bf16(silu_f(g1[2]) * a1[2], silu_f(g1[3]) * a1[3]);
                *(u32x4*)rowp = w; }
    }
};
template <class Epi, class Sched, bool ALIGN_EPI = false, bool SP2 = false>
__device__ __forceinline__ void gemm_phase(PG8_LAS unsigned char* lds, const Gemm g, const Sched& S, const Epi& E) {
    const int tid = threadIdx.x, wid = __builtin_amdgcn_readfirstlane(tid >> 6), lane = tid & 63, wr = wid >> 2, wc = wid & 3, fr = lane & 15, fq = lane >> 4;
    const int K = g.K, nt = K / BK;
    unsigned voffA[2], voffB[2];
#pragma unroll
    for (int i = 0; i < 2; ++i) { int R, C; stage_rc(tid * 16 + i * 8192, R, C); const int Rb = Epi::PERM ? ((R & ~31) + perm32(R & 31)) : R;
        voffA[i] = (unsigned)(R * K + C) * 2u; voffB[i] = (unsigned)(Rb * K + C) * 2u; }
    const size_t kstep = (size_t)(BK * 2);
    const size_t hstep = (size_t)HALF * K * 2;
    const size_t tstep = 2 * hstep;
    const unsigned ldsw = (unsigned)wid * 1024u;
    const int aoff = lds_byte(wr * 64 + fr, fq * 8), boff = lds_byte(wc * 32 + fr, fq * 8);
#define PG8_SA(b, h) (((b) * 2 + (h)) * HTB)
#define PG8_SB(b, h) ((4 + (b) * 2 + (h)) * HTB)
#define PG8_STAGE(bufoff, gbase, voff) do { _Pragma("unroll") for (int _i = 0; _i < 2; ++_i) \
        __builtin_amdgcn_global_load_lds((const unsigned*)((const char*)(gbase) + (voff)[_i]), (PG8_LAS unsigned*)(lds + (bufoff) + ldsw + _i * 8192), 16, 0, 0); } while (0)
#define PG8_LDA(dst, b, h) do { _Pragma("unroll") for (int m = 0; m < 4; ++m) _Pragma("unroll") for (int k = 0; k < 2; ++k) dst[m][k] = *(const PG8_LAS bf16x8*)(lds + PG8_SA(b, h) + aoff + m * 2048 + k * 1024); } while (0)
#define PG8_LDB(dst, b, h) do { _Pragma("unroll") for (int n = 0; n < 2; ++n) _Pragma("unroll") for (int k = 0; k < 2; ++k) dst[n][k] = *(const PG8_LAS bf16x8*)(lds + PG8_SB(b, h) + boff + n * 2048 + k * 1024); } while (0)
#define PG8_MMA(ai, bj, At, Bt) do { __builtin_amdgcn_s_setprio(1); _Pragma("unroll") for (int m = 0; m < 4; ++m) _Pragma("unroll") for (int n = 0; n < 2; ++n) _Pragma("unroll") for (int k = 0; k < 2; ++k) \
        acc[ai][bj][m][n] = __builtin_amdgcn_mfma_f32_16x16x32_bf16(Bt[n][k], At[m][k], acc[ai][bj][m][n], 0, 0, 0); __builtin_amdgcn_s_setprio(0); } while (0)
#define PG8_WAIT_V(n) asm volatile("s_waitcnt vmcnt(" #n ")" ::: "memory")
#define PG8_WAIT_L(n) asm volatile("s_waitcnt lgkmcnt(" #n ")" ::: "memory")
#define PG8_BAR __builtin_amdgcn_s_barrier()
#define PG8_SCHED __builtin_amdgcn_sched_barrier(0)
    Unit cur, nxt; int ui = 0;
    if (!S.next(0, cur)) return;
    f32x4 acc[2][2][4][2];
#pragma unroll
    for (int a = 0; a < 2; ++a)
#pragma unroll
        for (int b = 0; b < 2; ++b)
#pragma unroll
            for (int m = 0; m < 4; ++m)
#pragma unroll
                for (int n = 0; n < 2; ++n) acc[a][b][m][n] = (f32x4){0.f, 0.f, 0.f, 0.f};
    bf16x8 At[4][2], B0[2][2], B1[2][2];
    const char* cA = (const char*)g.A + (size_t)cur.pm * tstep; const char* cB = (const char*)g.Bt + (size_t)cur.pn * tstep;
    S.a_ready(cur);
    if constexpr (SP2) {
        PG8_STAGE(PG8_SB(0, 0), cB, voffB); PG8_STAGE(PG8_SB(0, 1), cB + hstep, voffB); PG8_STAGE(PG8_SA(0, 0), cA, voffA); PG8_STAGE(PG8_SA(0, 1), cA + hstep, voffA);
        if (wr == 1) PG8_BAR;
        PG8_WAIT_V(2); PG8_BAR;
        PG8_STAGE(PG8_SB(1, 0), cB + kstep, voffB); PG8_STAGE(PG8_SA(1, 0), cA + kstep, voffA); PG8_STAGE(PG8_SB(1, 1), cB + hstep + kstep, voffB);
        PG8_WAIT_V(6); PG8_BAR;
    } else {
        PG8_STAGE(PG8_SB(0, 0), cB, voffB); PG8_STAGE(PG8_SA(0, 0), cA, voffA); PG8_STAGE(PG8_SB(0, 1), cB + hstep, voffB); PG8_STAGE(PG8_SA(0, 1), cA + hstep, voffA);
        if (wr == 1) PG8_BAR;
        PG8_WAIT_V(4); PG8_BAR;
        PG8_STAGE(PG8_SB(1, 0), cB + kstep, voffB); PG8_STAGE(PG8_SA(1, 0), cA + kstep, voffA); PG8_STAGE(PG8_SB(1, 1), cB + hstep + kstep, voffB);
        PG8_WAIT_V(6); PG8_BAR;
    }
    for (;;) {
        const bool has_next = S.next(ui + 1, nxt);
        const char* nA = has_next ? (const char*)g.A + (size_t)nxt.pm * tstep : cA; const char* nB = has_next ? (const char*)g.Bt + (size_t)nxt.pn * tstep : cB;
        for (int t = 0; t < nt; t += 2) {
            const bool last = (t == nt - 2);
            const char* a1 = cA + (size_t)(t + 1) * kstep;
            const char* a2 = last ? nA : cA + (size_t)(t + 2) * kstep; const char* b2 = last ? nB : cB + (size_t)(t + 2) * kstep;
            const char* a3 = a2 + kstep; const char* b3 = b2 + kstep;
            if (last && has_next) S.a_ready(nxt);
            if constexpr (SP2) {
            PG8_LDB(B0, 0, 0); PG8_LDB(B1, 0, 1); PG8_SCHED; PG8_LDA(At, 0, 0); PG8_STAGE(PG8_SA(1, 1), a1 + hstep, voffA);
            PG8_WAIT_V(8); PG8_WAIT_L(0); PG8_BAR; PG8_MMA(0, 0, At, B0); PG8_MMA(0, 1, At, B1); PG8_BAR; PG8_SCHED;
            PG8_LDA(At, 0, 1); PG8_STAGE(PG8_SB(0, 0), b2, voffB); PG8_STAGE(PG8_SB(0, 1), b2 + hstep, voffB); PG8_STAGE(PG8_SA(0, 0), a2, voffA);
            PG8_WAIT_V(8); PG8_WAIT_L(0); PG8_BAR; PG8_MMA(1, 0, At, B0); PG8_MMA(1, 1, At, B1); PG8_BAR; PG8_SCHED;
            PG8_LDB(B0, 1, 0); PG8_LDB(B1, 1, 1); PG8_SCHED; PG8_LDA(At, 1, 0); PG8_STAGE(PG8_SA(0, 1), a2 + hstep, voffA);
            PG8_WAIT_V(8); PG8_WAIT_L(0); PG8_BAR; PG8_MMA(0, 0, At, B0); PG8_MMA(0, 1, At, B1); PG8_BAR; PG8_SCHED;
            PG8_LDA(At, 1, 1); PG8_STAGE(PG8_SB(1, 0), b3, voffB); PG8_STAGE(PG8_SB(1, 1), b3 + hstep, voffB); PG8_STAGE(PG8_SA(1, 0), a3, voffA);
            PG8_WAIT_V(8); PG8_WAIT_L(0); PG8_BAR; PG8_MMA(1, 0, At, B0); PG8_MMA(1, 1, At, B1); PG8_BAR; PG8_SCHED;
            } else {
            PG8_LDB(B0, 0, 0); PG8_SCHED; PG8_LDA(At, 0, 0); PG8_STAGE(PG8_SA(1, 1), a1 + hstep, voffA);
            PG8_WAIT_L(8); PG8_BAR; PG8_WAIT_L(0); PG8_MMA(0, 0, At, B0); PG8_BAR; PG8_SCHED;
            PG8_LDB(B1, 0, 1); PG8_STAGE(PG8_SB(0, 0), b2, voffB);
            PG8_BAR; PG8_WAIT_L(0); PG8_MMA(0, 1, At, B1); PG8_BAR;
            PG8_LDA(At, 0, 1); PG8_STAGE(PG8_SA(0, 0), a2, voffA);
            PG8_BAR; PG8_WAIT_L(0); PG8_MMA(1, 0, At, B0); PG8_BAR; PG8_SCHED;
            PG8_STAGE(PG8_SB(0, 1), b2 + hstep, voffB);
            PG8_WAIT_V(6); PG8_BAR; PG8_MMA(1, 1, At, B1); PG8_BAR;
            PG8_LDB(B0, 1, 0); PG8_SCHED; PG8_LDA(At, 1, 0); PG8_STAGE(PG8_SA(0, 1), a2 + hstep, voffA);
            PG8_WAIT_L(8); PG8_BAR; PG8_WAIT_L(0); PG8_MMA(0, 0, At, B0); PG8_BAR; PG8_SCHED;
            PG8_LDB(B1, 1, 1); PG8_STAGE(PG8_SB(1, 0), b3, voffB);
            PG8_BAR; PG8_WAIT_L(0); PG8_MMA(0, 1, At, B1); PG8_BAR;
            PG8_LDA(At, 1, 1); PG8_STAGE(PG8_SA(1, 0), a3, voffA);
            PG8_BAR; PG8_WAIT_L(0); PG8_MMA(1, 0, At, B0); PG8_BAR; PG8_SCHED;
            PG8_STAGE(PG8_SB(1, 1), b3 + hstep, voffB);
            PG8_WAIT_V(6); PG8_BAR; PG8_MMA(1, 1, At, B1); PG8_BAR;
            }
        }
        if constexpr (ALIGN_EPI) { if (wr == 0) PG8_BAR; }
        if constexpr (!Epi::AFTER_DRAIN) { E(acc, cur, wr, wc, fr, fq); S.done(cur); }
        if (!has_next) break;
#pragma unroll
        for (int a = 0; a < 2; ++a)
#pragma unroll
            for (int b = 0; b < 2; ++b)
#pragma unroll
                for (int m = 0; m < 4; ++m)
#pragma unroll
                    for (int n = 0; n < 2; ++n) acc[a][b][m][n] = (f32x4){0.f, 0.f, 0.f, 0.f};
        cur = nxt; cA = nA; cB = nB; ++ui;
        if constexpr (ALIGN_EPI) { if (wr == 1) PG8_BAR; }
    }
    PG8_WAIT_V(0);
    if constexpr (!ALIGN_EPI) { if (wr == 0) PG8_BAR; }
    PG8_BAR;
    if constexpr (Epi::AFTER_DRAIN) { E.fused(acc, cur, wr, wc, fr, fq, lds, wid, lane); S.done(cur); }
#undef PG8_SA
#undef PG8_SB
#undef PG8_STAGE
#undef PG8_LDA
#undef PG8_LDB
#undef PG8_MMA
#undef PG8_WAIT_V
#undef PG8_WAIT_L
#undef PG8_BAR
#undef PG8_SCHED
}
}

constexpr int NWAVES = 8, NTHR = NWAVES * 64;
constexpr int DM = 1024, NB = 16, SEQ = 2048, CTXL = 256;
constexpr int ML = NB * SEQ;
constexpr int MC = NB * CTXL;
constexpr int MT = ML + MC;
constexpr int NP = 2048;
constexpr int INW = 2064;
constexpr int DFF = 2816;
constexpr int NHEAD = 4, DK = 64, DV = 128;
constexpr float EPS = 1e-6f;
constexpr int NMOD = 6 * DM;
constexpr int ADA_KB = 16;

constexpr size_t MiB = 1u << 20;
constexpr size_t WS_CTL = 0;
constexpr size_t WS_MODP = 1 * MiB;
constexpr size_t WS_MOD = 8 * MiB;
constexpr size_t WS_WG = 9 * MiB;
constexpr size_t WS_POOLW = 9 * MiB + 512 * 1024;
constexpr size_t WS_WIN = 10 * MiB;
constexpr size_t WS_WOUT = 14 * MiB;
constexpr size_t WS_WUP = 16 * MiB;
constexpr size_t WS_WDN = 27 * MiB;
constexpr size_t WS_GATES = 33 * MiB;
constexpr size_t WS_HX = 36 * MiB;
constexpr size_t WS_P = 108 * MiB;
constexpr size_t WS_QK = 252 * MiB;
constexpr size_t WS_HID = WS_P;
constexpr size_t WS_MIX = 288 * MiB;
constexpr size_t WS_HF = 352 * MiB;
constexpr size_t WS_HB = 416 * MiB;
constexpr size_t WS_END = 480 * MiB;
static_assert(WS_HID + (size_t)ML * DFF * 2 <= WS_MIX, "hidden overlay");

constexpr int LDS_BYTES = 147456;
constexpr int RING_BYTES = 131072;

#define GAS __attribute__((address_space(1)))
#define LAS __attribute__((address_space(3)))
typedef unsigned short bf16;
typedef float f32x4 __attribute__((ext_vector_type(4)));
typedef float f32x2 __attribute__((ext_vector_type(2)));
typedef unsigned u32x4 __attribute__((ext_vector_type(4)));
typedef unsigned u32x2 __attribute__((ext_vector_type(2)));
#define LDS_WAIT() asm volatile("s_waitcnt lgkmcnt(0)" ::: "memory")

__device__ __forceinline__ float bf2f(unsigned short b) { return __uint_as_float((unsigned)b << 16); }
__device__ __forceinline__ float bflo(unsigned w) { return __uint_as_float(w << 16); }
__device__ __forceinline__ float bfhi(unsigned w) { return __uint_as_float(w & 0xffff0000u); }
__device__ __forceinline__ unsigned pk2(float lo, float hi) { return pg8::cvt_pk_bf16(lo, hi); }
__device__ __forceinline__ float wave_sum(float v) {
#pragma unroll
    for (int o = 1; o < 64; o <<= 1) v += __shfl_xor(v, o);
    return v;
}
__device__ __forceinline__ float silu_acc(float x) { return x / (1.0f + __expf(-x)); }

struct Args {
    const float *x, *c, *ctx, *c_ctx, *w_ada, *b_ada, *norm1, *w_in, *conv_qk, *gate_bias, *pool_w, *pool_scale, *head_norm, *w_out, *norm2, *w_up, *w_down, *norm_f;
    float* out; unsigned char* ws; int ph_lo, ph_hi;
};

__device__ __forceinline__ void tr_item(const float* W, int ldw, bf16* WT, int K, int k0, int n0, int drow0, LAS float* scr, int lane) {
#pragma unroll 8
    for (int i = 0; i < 32; ++i) { const int kk = 2 * i + (lane >> 5); scr[kk * 33 + (lane & 31)] = W[(size_t)(k0 + kk) * ldw + n0 + (lane & 31)]; }
    LDS_WAIT(); asm volatile("" ::: "memory");
    const int c = lane & 7;
#pragma unroll
    for (int j = 0; j < 4; ++j) { const int n = (lane >> 3) + 8 * j; const LAS float* s = scr + (8 * c) * 33 + n;
        u32x4 o; o.x = pk2(s[0 * 33], s[1 * 33]); o.y = pk2(s[2 * 33], s[3 * 33]); o.z = pk2(s[4 * 33], s[5 * 33]); o.w = pk2(s[6 * 33], s[7 * 33]);
        *(u32x4*)(WT + (size_t)(drow0 + n) * K + k0 + 8 * c) = o; }
    LDS_WAIT(); asm volatile("" ::: "memory");
}
__device__ __forceinline__ void phase0(const Args& a, LAS unsigned char* lds, int G) {
    const int tid = threadIdx.x, lane = tid & 63, wave = __builtin_amdgcn_readfirstlane(tid >> 6);
    LAS float* scr = (LAS float*)(lds + wave * 16384);
    const int gw = blockIdx.x * NWAVES + wave, NGW = G * NWAVES;
    unsigned char* ws = a.ws;
    bf16* win_t = (bf16*)(ws + WS_WIN); bf16* wout_t = (bf16*)(ws + WS_WOUT); bf16* wup_t = (bf16*)(ws + WS_WUP); bf16* wdn_t = (bf16*)(ws + WS_WDN); bf16* poolw_t = (bf16*)(ws + WS_POOLW);
    constexpr int I_IN = 16 * 64, I_OUT = 16 * 32, I_UP = 16 * 176, I_DN = 44 * 32, I_PW = 32, I_ADA = 24 * ADA_KB;
    constexpr int NITEMS = I_ADA + I_IN + I_OUT + I_UP + I_DN + I_PW;
    for (int it = gw; it < NITEMS; it += NGW) {
        int r = it;
        if (r < I_ADA) {
            const int cb = r / ADA_KB, kb = r % ADA_KB, k0 = kb * 64, col = cb * 256 + lane * 4;
            for (int idx = lane; idx < 17 * 64; idx += 64) { const int rr = idx >> 6, kk = idx & 63; const float cv = rr < 16 ? a.c[rr * DM + k0 + kk] : a.c_ctx[k0 + kk]; scr[idx] = silu_acc(cv); }
            LDS_WAIT(); asm volatile("" ::: "memory");
            f32x4 acc[17];
#pragma unroll
            for (int rr = 0; rr < 17; ++rr) acc[rr] = (f32x4){0.f, 0.f, 0.f, 0.f};
            for (int kk = 0; kk < 64; ++kk) { const f32x4 w = *(const f32x4*)(a.w_ada + (size_t)(k0 + kk) * NMOD + col);
#pragma unroll
                for (int rr = 0; rr < 17; ++rr) acc[rr] += scr[rr * 64 + kk] * w; }
            if (kb == 0) { const f32x4 bv = *(const f32x4*)(a.b_ada + col);
#pragma unroll
                for (int rr = 0; rr < 17; ++rr) acc[rr] += bv; }
            float* mp = (float*)(ws + WS_MODP) + (size_t)kb * 17 * NMOD + col;
#pragma unroll
            for (int rr = 0; rr < 17; ++rr) *(f32x4*)(mp + (size_t)rr * NMOD) = acc[rr];
            LDS_WAIT(); asm volatile("" ::: "memory");
            continue; }
        r -= I_ADA;
        if (r < I_IN) { const int kb = r / 64, nb = r % 64; tr_item(a.w_in, INW, win_t, DM, kb * 64, nb * 32, nb * 32, scr, lane); continue; } r -= I_IN;
        if (r < I_OUT) { const int kb = r / 32, nb = r % 32; tr_item(a.w_out, DM, wout_t, DM, kb * 64, nb * 32, nb * 32, scr, lane); continue; } r -= I_OUT;
        if (r < I_UP) { const int kb = r / 176, nb = r % 176; const int c0 = nb * 32; int drow0;
            if (c0 < DFF) drow0 = 256 * (c0 / 128) + (c0 % 128); else { const int c1 = c0 - DFF; drow0 = 256 * (c1 / 128) + 128 + (c1 % 128); }
            tr_item(a.w_up, 2 * DFF, wup_t, DM, kb * 64, c0, drow0, scr, lane); continue; } r -= I_UP;
        if (r < I_DN) { const int kb = r / 32, nb = r % 32; tr_item(a.w_down, DM, wdn_t, DFF, kb * 64, nb * 32, nb * 32, scr, lane); continue; } r -= I_DN;
        { const int g = r / 8, q = r % 8, kb = q / 4, nb = q % 4; tr_item(a.pool_w + g * 16384, 128, poolw_t + g * 16384, 128, kb * 64, nb * 32, nb * 32, scr, lane); }
    }
    float* wg = (float*)(ws + WS_WG);
    for (int idx = blockIdx.x * NTHR + tid; idx < 16 * DM; idx += G * NTHR) { const int k = idx >> 4, j = idx & 15; wg[j * DM + k] = a.w_in[(size_t)k * INW + 2048 + j]; }
}

__device__ __forceinline__ float logsigmoid_f(float v) { return fminf(v, 0.f) - log1pf(__expf(-fabsf(v))); }
__device__ __forceinline__ float reduce16(float (&v)[16], int lane) {
    { const bool up = (lane & 32) != 0;
#pragma unroll
      for (int j = 0; j < 8; ++j) { const float send = up ? v[j] : v[j + 8]; const float keep = up ? v[j + 8] : v[j]; v[j] = keep + __shfl_xor(send, 32); } }
    { const bool up = (lane & 16) != 0;
#pragma unroll
      for (int j = 0; j < 4; ++j) { const float send = up ? v[j] : v[j + 4]; const float keep = up ? v[j + 4] : v[j]; v[j] = keep + __shfl_xor(send, 16); } }
    { const bool up = (lane & 8) != 0;
#pragma unroll
      for (int j = 0; j < 2; ++j) { const float send = up ? v[j] : v[j + 2]; const float keep = up ? v[j + 2] : v[j]; v[j] = keep + __shfl_xor(send, 8); } }
    { const bool up = (lane & 4) != 0; const float send = up ? v[0] : v[1]; const float keep = up ? v[1] : v[0]; v[0] = keep + __shfl_xor(send, 4); }
    float s = v[0]; s += __shfl_xor(s, 1); s += __shfl_xor(s, 2); return s;
}
__device__ __forceinline__ void p1_pair(const Args& a, const float* xr0, const float* xr1, int orow0, int orow1, const LAS float* S, const LAS float* H, const LAS float* WgL, int lane) {
    bf16* hx = (bf16*)(a.ws + WS_HX); float* gates = (float*)(a.ws + WS_GATES);
    float s0 = 0.f, s1 = 0.f;
#pragma unroll
    for (int j = 0; j < 4; ++j) { const f32x4 v0 = *(const f32x4*)(xr0 + 4 * lane + 256 * j), v1 = *(const f32x4*)(xr1 + 4 * lane + 256 * j);
        s0 += (v0.x * v0.x + v0.y * v0.y) + (v0.z * v0.z + v0.w * v0.w); s1 += (v1.x * v1.x + v1.y * v1.y) + (v1.z * v1.z + v1.w * v1.w); }
    const float r0 = rsqrtf(wave_sum(s0) * (1.f / DM) + EPS), r1 = rsqrtf(wave_sum(s1) * (1.f / DM) + EPS);
    float g0[16], g1[16];
#pragma unroll
    for (int g = 0; g < 16; ++g) { g0[g] = 0.f; g1[g] = 0.f; }
#pragma unroll 1
    for (int j = 0; j < 4; ++j) { const int k = 4 * lane + 256 * j;
        const f32x4 v0 = *(const f32x4*)(xr0 + k), v1 = *(const f32x4*)(xr1 + k);
        const f32x4 sv = *(const LAS f32x4*)(S + k), hv = *(const LAS f32x4*)(H + k);
        const f32x4 h0 = (v0 * r0) * sv + hv, h1 = (v1 * r1) * sv + hv;
        u32x2 w0, w1; w0.x = pk2(h0.x, h0.y); w0.y = pk2(h0.z, h0.w); w1.x = pk2(h1.x, h1.y); w1.y = pk2(h1.z, h1.w);
        *(u32x2*)(hx + (size_t)orow0 * DM + k) = w0; *(u32x2*)(hx + (size_t)orow1 * DM + k) = w1;
#pragma unroll
        for (int g = 0; g < 16; ++g) { const f32x4 wv = *(const LAS f32x4*)(WgL + g * DM + k);
            g0[g] += (h0.x * wv.x + h0.y * wv.y) + (h0.z * wv.z + h0.w * wv.w); g1[g] += (h1.x * wv.x + h1.y * wv.y) + (h1.z * wv.z + h1.w * wv.w); } }
    const float t0 = reduce16(g0, lane), t1 = reduce16(g1, lane);
    if ((lane & 3) == 0) { const int g = ((lane >> 5) & 1) * 8 + ((lane >> 4) & 1) * 4 + ((lane >> 3) & 1) * 2 + ((lane >> 2) & 1);
        const float bias = a.gate_bias[g]; float y0 = t0 + bias, y1 = t1 + bias;
        if (g >= 8) { y0 = logsigmoid_f(y0); y1 = logsigmoid_f(y1); }
        gates[(size_t)orow0 * 16 + g] = y0; gates[(size_t)orow1 * 16 + g] = y1; }
}
__device__ __forceinline__ void phase1(const Args& a, LAS unsigned char* lds, int G) {
    const int tid = threadIdx.x, lane = tid & 63, wave = __builtin_amdgcn_readfirstlane(tid >> 6);
    LAS float* S1 = (LAS float*)lds; LAS float* H1 = S1 + DM; LAS float* S1c = H1 + DM; LAS float* H1c = S1c + DM; LAS float* WgL = H1c + DM;
    const float* modp = (const float*)(a.ws + WS_MODP); float* mod = (float*)(a.ws + WS_MOD); const float* wg = (const float*)(a.ws + WS_WG);
    for (int rg = blockIdx.x; rg < 256; rg += G) {
        const int b = rg >> 4, sub = rg & 15;
        __syncthreads();
#pragma unroll 1
        for (int idx = tid; idx < DM; idx += NTHR) { float sh = 0.f, sc = 0.f, shc = 0.f, scc = 0.f;
#pragma unroll 4
            for (int kb = 0; kb < ADA_KB; ++kb) { const float* p = modp + (size_t)kb * 17 * NMOD; sh += p[b * NMOD + idx]; sc += p[b * NMOD + DM + idx]; shc += p[16 * NMOD + idx]; scc += p[16 * NMOD + DM + idx]; }
            const float n1 = a.norm1[idx]; S1[idx] = n1 * (1.f + sc); H1[idx] = sh; S1c[idx] = n1 * (1.f + scc); H1c[idx] = shc; }
        if (sub == 0)
#pragma unroll 1
          for (int idx = tid; idx < NMOD; idx += NTHR) { float s = 0.f;
#pragma unroll 4
            for (int kb = 0; kb < ADA_KB; ++kb) s += modp[(size_t)kb * 17 * NMOD + b * NMOD + idx]; mod[b * NMOD + idx] = s; }
#pragma unroll 2
        for (int idx = tid; idx < 16 * DM / 4; idx += NTHR) *(LAS f32x4*)(WgL + 4 * idx) = *(const f32x4*)(wg + 4 * idx);
        __syncthreads();
        const int lr0 = b * SEQ + sub * 128 + wave * 16;
#pragma unroll 1
        for (int i = 0; i < 16; i += 2) p1_pair(a, a.x + (size_t)(lr0 + i) * DM, a.x + (size_t)(lr0 + i + 1) * DM, lr0 + i, lr0 + i + 1, S1, H1, WgL, lane);
        const int cr0 = b * CTXL + sub * 16 + wave * 2;
        p1_pair(a, a.ctx + (size_t)cr0 * DM, a.ctx + (size_t)(cr0 + 1) * DM, ML + cr0, ML + cr0 + 1, S1c, H1c, WgL, lane);
    }
}

__device__ __forceinline__ void phase2b(const Args& a, int G) {
    const int tid = threadIdx.x, lane = tid & 63, wave = __builtin_amdgcn_readfirstlane(tid >> 6);
    const int gw = blockIdx.x * NWAVES + wave, NGW = G * NWAVES;
    const bf16* P = (const bf16*)(a.ws + WS_P); bf16* QK = (bf16*)(a.ws + WS_QK);
    const int c0 = lane * 8;
    float w0[8], w1[8], w2[8];
#pragma unroll
    for (int e = 0; e < 8; ++e) { w0[e] = a.conv_qk[c0 + e]; w1[e] = a.conv_qk[512 + c0 + e]; w2[e] = a.conv_qk[1024 + c0 + e]; }
    const float qs = (c0 < 256) ? 0.125f : 1.0f;
    for (int it = gw; it < MT / 16; it += NGW) {
        const int r0 = it * 16;
        const int t0 = (r0 < ML) ? (r0 % SEQ) : ((r0 - ML) % CTXL); const int tlen = (r0 < ML) ? SEQ : CTXL;
        u32x4 prev = (u32x4){0u, 0u, 0u, 0u}, cur, nxt;
        if (t0 != 0) prev = *(const u32x4*)(P + (size_t)(r0 - 1) * NP + 512 + c0);
        cur = *(const u32x4*)(P + (size_t)r0 * NP + 512 + c0);
        for (int i = 0; i < 16; ++i) {
            const bool has_next = (i < 15) || (t0 + 16 != tlen);
            nxt = (u32x4){0u, 0u, 0u, 0u};
            if (has_next) nxt = *(const u32x4*)(P + (size_t)(r0 + i + 1) * NP + 512 + c0);
            float y[8];
#pragma unroll
            for (int e = 0; e < 4; ++e) {
                y[2 * e] = w0[2 * e] * bflo(prev[e]) + w1[2 * e] * bflo(cur[e]) + w2[2 * e] * bflo(nxt[e]);
                y[2 * e + 1] = w0[2 * e + 1] * bfhi(prev[e]) + w1[2 * e + 1] * bfhi(cur[e]) + w2[2 * e + 1] * bfhi(nxt[e]); }
            u32x4 o;
#pragma unroll
            for (int e = 0; e < 4; ++e) o[e] = pk2(silu_acc(y[2 * e]) * qs, silu_acc(y[2 * e + 1]) * qs);
            *(u32x4*)(QK + (size_t)(r0 + i) * 512 + c0) = o;
            prev = cur; cur = nxt;
        }
    }
}

__device__ __forceinline__ void phase3_pool(const Args& a, LAS unsigned char* lds, int G) {
    const int tid = threadIdx.x;
    const bf16* P = (const bf16*)(a.ws + WS_P); bf16* MIX = (bf16*)(a.ws + WS_MIX);
    LAS float* dS = (LAS float*)lds;
    for (int it = blockIdx.x; it < (ML / 64) * 4; it += G) {
        const int tb = it >> 2, g = it & 3, tok0 = tb * 64, half = 1 << g;
        __syncthreads();
        for (int i = 0; i < 16; ++i) { const int idx = tid + NTHR * i, p = idx >> 7, c = idx & 127;
            int lo = p - half; if (lo < 0) lo = 0; int hi = p + half - 1; if (hi > 63) hi = 63;
            float s = 0.f; for (int q = lo; q <= hi; ++q) s += bf2f(P[(size_t)(tok0 + q) * NP + g * 128 + c]);
            dS[p * 128 + c] = s / (float)(hi - lo + 1) - bf2f(P[(size_t)(tok0 + p) * NP + g * 128 + c]); }
        __syncthreads();
        const int n = tid & 127, pq = tid >> 7;
        float acc[16];
#pragma unroll
        for (int i = 0; i < 16; ++i) acc[i] = 0.f;
        const float* W = a.pool_w + g * 16384 + n;
        for (int c = 0; c < 128; ++c) { const float w = W[c * 128];
#pragma unroll
            for (int i = 0; i < 16; ++i) acc[i] += dS[(pq + 4 * i) * 128 + c] * w; }
        const float ps = a.pool_scale[g * 128 + n];
#pragma unroll
        for (int i = 0; i < 16; ++i) { const unsigned w = pk2(acc[i] * ps, 0.f); MIX[(size_t)(tok0 + pq + 4 * i) * DM + g * 128 + n] = (bf16)(w & 0xffffu); }
    }
}

__device__ __forceinline__ void phase3_mlstm(const Args& a, LAS unsigned char* lds, int G) {
    const int tid = threadIdx.x;
    const bf16* P = (const bf16*)(a.ws + WS_P); const bf16* QK = (const bf16*)(a.ws + WS_QK); const float* gates = (const float*)(a.ws + WS_GATES);
    LAS float* qS = (LAS float*)lds; LAS float* kS = qS + 64 * 64; LAS float* vS = kS + 64 * 64; LAS float* igS = vS + 64 * 128; LAS float* lfS = igS + 64;
    const int v = tid >> 2, dq = tid & 3;
    for (int it = blockIdx.x; it < NB * NHEAD * 2; it += G) {
        const int dir = it & 1, hh = (it >> 1) & 3, b = it >> 3;
        float* H = (float*)(a.ws + (dir ? WS_HB : WS_HF));
        float C[16], nn[16]; float m = 0.f;
#pragma unroll
        for (int d = 0; d < 16; ++d) { C[d] = 0.f; nn[d] = 0.f; }
        for (int seg = 0; seg < 2; ++seg) {
            const int tlen = seg ? SEQ : CTXL; const int rbase = seg ? b * SEQ : ML + b * CTXL;
            for (int ch = 0; ch < tlen / 64; ++ch) {
                __syncthreads();
                for (int i = 0; i < 4; ++i) { const int idx = tid + NTHR * i, jj = idx >> 5, cix = idx & 31;
                    const int st = ch * 64 + jj, t = dir ? (tlen - 1 - st) : st; const size_t row = (size_t)(rbase + t);
                    const bf16* src; LAS float* dst;
                    if (cix < 8) { src = QK + row * 512 + hh * 64 + cix * 8; dst = qS + jj * 64 + cix * 8; }
                    else if (cix < 16) { src = QK + row * 512 + 256 + hh * 64 + (cix - 8) * 8; dst = kS + jj * 64 + (cix - 8) * 8; }
                    else { src = P + row * NP + 1024 + hh * 128 + (cix - 16) * 8; dst = vS + jj * 128 + (cix - 16) * 8; }
                    const u32x4 w = *(const u32x4*)src;
#pragma unroll
                    for (int e = 0; e < 4; ++e) { dst[2 * e] = bflo(w[e]); dst[2 * e + 1] = bfhi(w[e]); } }
                if (tid < 64) { const int st = ch * 64 + tid, t = dir ? (tlen - 1 - st) : st; const size_t row = (size_t)(rbase + t);
                    igS[tid] = gates[row * 16 + dir * 4 + hh]; lfS[tid] = gates[row * 16 + 8 + dir * 4 + hh]; }
                __syncthreads();
                for (int jj = 0; jj < 64; ++jj) {
                    const float ig = igS[jj], lf = lfS[jj];
                    const float mn = fmaxf(lf + m, ig), fd = __expf(lf + m - mn), iw = __expf(ig - mn); m = mn;
                    const float vv = vS[jj * 128 + v] * iw;
                    float num = 0.f, den = 0.f;
#pragma unroll
                    for (int d4 = 0; d4 < 4; ++d4) { const f32x4 kk = *(const LAS f32x4*)(kS + jj * 64 + dq * 16 + d4 * 4), qq = *(const LAS f32x4*)(qS + jj * 64 + dq * 16 + d4 * 4);
#pragma unroll
                        for (int e = 0; e < 4; ++e) { const int d = d4 * 4 + e; C[d] = fd * C[d] + vv * kk[e]; nn[d] = fd * nn[d] + iw * kk[e]; num += C[d] * qq[e]; den += nn[d] * qq[e]; } }
                    num += __shfl_xor(num, 1); num += __shfl_xor(num, 2); den += __shfl_xor(den, 1); den += __shfl_xor(den, 2);
                    if (seg && dq == 0) { const int st = ch * 64 + jj, t = dir ? (tlen - 1 - st) : st;
                        H[(size_t)(rbase + t) * 512 + hh * 128 + v] = num / fmaxf(fabsf(den), __expf(-m)); }
                }
            }
        }
    }
}

__device__ __forceinline__ void phase4(const Args& a, int G) {
    const int tid = threadIdx.x, lane = tid & 63, wave = __builtin_amdgcn_readfirstlane(tid >> 6);
    const int gw = blockIdx.x * NWAVES + wave, NGW = G * NWAVES;
    const bf16* P = (const bf16*)(a.ws + WS_P); bf16* MIX = (bf16*)(a.ws + WS_MIX); const float* HF = (const float*)(a.ws + WS_HF); const float* HB = (const float*)(a.ws + WS_HB);
    const int c0 = lane * 8;
    float hn[8];
#pragma unroll
    for (int e = 0; e < 8; ++e) hn[e] = a.head_norm[c0 + e];
    for (int row = gw; row < ML; row += NGW) {
        const f32x4 f0 = *(const f32x4*)(HF + (size_t)row * 512 + c0), f1 = *(const f32x4*)(HF + (size_t)row * 512 + c0 + 4);
        const f32x4 b0 = *(const f32x4*)(HB + (size_t)row * 512 + c0), b1 = *(const f32x4*)(HB + (size_t)row * 512 + c0 + 4);
        const u32x4 ow = *(const u32x4*)(P + (size_t)row * NP + 1536 + c0);
        float h[8];
#pragma unroll
        for (int e = 0; e < 4; ++e) { h[e] = f0[e] + b0[e]; h[4 + e] = f1[e] + b1[e]; }
        float ss = 0.f;
#pragma unroll
        for (int e = 0; e < 8; ++e) ss += h[e] * h[e];
        ss += __shfl_xor(ss, 1); ss += __shfl_xor(ss, 2); ss += __shfl_xor(ss, 4); ss += __shfl_xor(ss, 8);
        const float r = rsqrtf(ss * (1.f / DV) + EPS);
        float o[8];
#pragma unroll
        for (int e = 0; e < 4; ++e) { o[2 * e] = bflo(ow[e]); o[2 * e + 1] = bfhi(ow[e]); }
        u32x4 w;
#pragma unroll
        for (int e = 0; e < 4; ++e) { const float y0 = h[2 * e] * r * hn[2 * e] / (1.f + __expf(-o[2 * e])), y1 = h[2 * e + 1] * r * hn[2 * e + 1] / (1.f + __expf(-o[2 * e + 1])); w[e] = pk2(y0, y1); }
        *(u32x4*)(MIX + (size_t)row * DM + 512 + c0) = w;
    }
}

template <bool FINAL> __device__ __forceinline__ void phase_rownorm(const Args& a, int G) {
    const int tid = threadIdx.x, lane = tid & 63, wave = __builtin_amdgcn_readfirstlane(tid >> 6);
    const int gw = blockIdx.x * NWAVES + wave, NGW = G * NWAVES;
    const float* mod = (const float*)(a.ws + WS_MOD); bf16* h2 = (bf16*)(a.ws + WS_HX);
    for (int row = gw; row < ML; row += NGW) {
        float* xr = a.out + (size_t)row * DM;
        f32x4 v[4]; float s = 0.f;
#pragma unroll
        for (int j = 0; j < 4; ++j) { v[j] = *(const f32x4*)(xr + 4 * lane + 256 * j); s += (v[j].x * v[j].x + v[j].y * v[j].y) + (v[j].z * v[j].z + v[j].w * v[j].w); }
        const float r = rsqrtf(wave_sum(s) * (1.f / DM) + EPS);
        if (FINAL) {
#pragma unroll
            for (int j = 0; j < 4; ++j) { const f32x4 nf = *(const f32x4*)(a.norm_f + 4 * lane + 256 * j); *(f32x4*)(xr + 4 * lane + 256 * j) = (v[j] * r) * nf; }
        } else {
            const int b = row / SEQ; const float* mp = mod + (size_t)b * NMOD;
#pragma unroll
            for (int j = 0; j < 4; ++j) { const int k = 4 * lane + 256 * j; const f32x4 n2 = *(const f32x4*)(a.norm2 + k), sh = *(const f32x4*)(mp + 3 * DM + k), sc = *(const f32x4*)(mp + 4 * DM + k);
                const f32x4 h = ((v[j] * r) * n2) * (sc + 1.0f) + sh; u32x2 w; w.x = pk2(h.x, h.y); w.y = pk2(h.z, h.w); *(u32x2*)(h2 + (size_t)row * DM + k) = w; }
        }
    }
}

constexpr int N_PHASES = 11;
__global__ void __launch_bounds__(NTHR, 2) fwd_kernel(Args a) {
    extern __shared__ __attribute__((aligned(16))) unsigned char lds_raw[];
    LAS unsigned char* lds = (LAS unsigned char*)lds_raw;
    const int G = gridDim.x;
    const int lo = a.ph_lo, hi = a.ph_hi;
    cg::grid_group grid = cg::this_grid();
#ifndef PHASE_MASK
#define PHASE_MASK 0x7ff
#endif
#define IN(k) ((((PHASE_MASK) >> (k)) & 1) && lo <= (k) && (k) < hi)
#define SEAM(k) do { if (IN(k) && IN((k) + 1)) grid.sync(); } while (0)
    unsigned char* ws = a.ws;
    if (IN(0)) { phase0(a, lds, G); } SEAM(0);
    if (IN(1)) { phase1(a, lds, G); } SEAM(1);
    if (IN(2)) {
        pg8::Gemm g{(const bf16*)(ws + WS_HX), (const bf16*)(ws + WS_WIN), MT, NP, DM}; pg8::StaticOrder S; S.init(MT, NP, G, (int)blockIdx.x);
        pg8::EpiBf16Plain E{(bf16*)(ws + WS_P), NP};
        pg8::gemm_phase<pg8::EpiBf16Plain, pg8::StaticOrder, true, true>(lds, g, S, E);
    } SEAM(2);
    if (IN(3)) { phase2b(a, G); } SEAM(3);
    if (IN(4)) { phase3_pool(a, lds, G); phase3_mlstm(a, lds, G); } SEAM(4);
    if (IN(5)) { phase4(a, G); } SEAM(5);
    if (IN(6)) {
        pg8::Gemm g{(const bf16*)(ws + WS_MIX), (const bf16*)(ws + WS_WOUT), ML, DM, DM}; pg8::StaticOrder S; S.init(ML, DM, G, (int)blockIdx.x);
        pg8::EpiResGate E{a.x, a.out, DM, (const float*)(ws + WS_MOD) + 2 * DM, NMOD, SEQ / 256};
        pg8::gemm_phase<pg8::EpiResGate, pg8::StaticOrder, true, true>(lds, g, S, E);
    } SEAM(6);
    if (IN(7)) { phase_rownorm<false>(a, G); } SEAM(7);
    if (IN(8)) {
        pg8::Gemm g{(const bf16*)(ws + WS_HX), (const bf16*)(ws + WS_WUP), ML, 2 * DFF, DM}; pg8::StaticOrder S; S.init(ML, 2 * DFF, G, (int)blockIdx.x);
        pg8::EpiSwiglu E{(bf16*)(ws + WS_HID), DFF};
        pg8::gemm_phase<pg8::EpiSwiglu, pg8::StaticOrder, true, true>(lds, g, S, E);
    } SEAM(8);
    if (IN(9)) {
        pg8::Gemm g{(const bf16*)(ws + WS_HID), (const bf16*)(ws + WS_WDN), ML, DM, DFF}; pg8::StaticOrder S; S.init(ML, DM, G, (int)blockIdx.x);
        pg8::EpiResGate E{a.out, a.out, DM, (const float*)(ws + WS_MOD) + 5 * DM, NMOD, SEQ / 256};
        pg8::gemm_phase<pg8::EpiResGate, pg8::StaticOrder, true, true>(lds, g, S, E);
    } SEAM(9);
    if (IN(10)) { phase_rownorm<true>(a, G); }
#undef IN
#undef SEAM
}

#ifndef N_LAUNCHES
#define N_LAUNCHES 1
#endif
extern "C" void kernel_launch(void* const* d_in, const int* in_sizes, int n_in, void* d_out, int out_size, void* d_ws, size_t ws_size, hipStream_t stream) {
    static int grid = 0;
    if (grid == 0) {
        if (n_in != 18 || out_size != ML * DM || ws_size < WS_END) { fprintf(stderr, "kernel_launch: unexpected shapes (n_in %d out %d ws %zu)\n", n_in, out_size, ws_size); grid = -1; return; }
        int dev = 0, cus = 0, per_cu = 0;
        hipGetDevice(&dev); hipDeviceGetAttribute(&cus, hipDeviceAttributeMultiprocessorCount, dev);
        if (hipFuncSetAttribute((const void*)fwd_kernel, hipFuncAttributeMaxDynamicSharedMemorySize, LDS_BYTES) != hipSuccess) { fprintf(stderr, "kernel_launch: hipFuncSetAttribute failed\n"); grid = -1; return; }
        if (hipOccupancyMaxActiveBlocksPerMultiprocessor(&per_cu, (const void*)fwd_kernel, NTHR, LDS_BYTES) != hipSuccess || per_cu < 1) { fprintf(stderr, "kernel_launch: occupancy query says %d\n", per_cu); per_cu = 1; }
        (void)hipGetLastError();
        grid = cus * (per_cu > 1 ? 1 : per_cu);
        if (grid <= 0) grid = 256;
    }
    if (grid < 0) return;
    Args a{};
    a.x = (const float*)d_in[0]; a.c = (const float*)d_in[1]; a.ctx = (const float*)d_in[2]; a.c_ctx = (const float*)d_in[3]; a.w_ada = (const float*)d_in[4]; a.b_ada = (const float*)d_in[5];
    a.norm1 = (const float*)d_in[6]; a.w_in = (const float*)d_in[7]; a.conv_qk = (const float*)d_in[8]; a.gate_bias = (const float*)d_in[9]; a.pool_w = (const float*)d_in[10]; a.pool_scale = (const float*)d_in[11];
    a.head_norm = (const float*)d_in[12]; a.w_out = (const float*)d_in[13]; a.norm2 = (const float*)d_in[14]; a.w_up = (const float*)d_in[15]; a.w_down = (const float*)d_in[16]; a.norm_f = (const float*)d_in[17];
    a.out = (float*)d_out; a.ws = (unsigned char*)d_ws;
#if N_LAUNCHES == 1
    a.ph_lo = 0; a.ph_hi = N_PHASES;
    void* args[] = {&a};
    hipError_t e = hipLaunchCooperativeKernel((const void*)fwd_kernel, dim3(grid), dim3(NTHR), args, LDS_BYTES, stream);
    if (e != hipSuccess) fprintf(stderr, "cooperative launch failed: %s (grid %d)\n", hipGetErrorString(e), grid);
#else
    for (int p = 0; p < N_PHASES; ++p) { a.ph_lo = p; a.ph_hi = p + 1; hipLaunchKernelGGL(fwd_kernel, dim3(grid), dim3(NTHR), LDS_BYTES, stream, a); }
#endif
}
```

```cpp
#include <hip/hip_runtime.h>
#include <hip/hip_cooperative_groups.h>
#include <cstdio>
#include <cstdint>
namespace cg = cooperative_groups;
namespace pg8 {
#define PG8_LAS __attribute__((address_space(3)))
typedef unsigned short bf16_t;
typedef short bf16x8 __attribute__((ext_vector_type(8)));
typedef float f32x4 __attribute__((ext_vector_type(4)));
typedef unsigned u32x4 __attribute__((ext_vector_type(4)));
constexpr int BM = 256, BK = 64, HALF = 128, HTB = HALF * BK * 2  , STAGE_BYTES = 8 * HTB, NXCD = 8, WGM = 8;

__host__ __device__ __forceinline__ int lds_byte(int r, int c) { const int st = (r >> 4) * 2 + (c >> 5), rr = r & 15, cc = c & 31, ob = rr * 64 + cc * 2; return st * 1024 + (ob ^ (((ob >> 9) & 1) << 5)); }
__host__ __device__ __forceinline__ void stage_rc(int b, int& R, int& C) { const int st = b / 1024, sb = b % 1024, swz = sb ^ (((sb >> 9) & 1) << 5); R = (st >> 1) * 16 + swz / 64; C = (st & 1) * 32 + (swz % 64) / 2; }
__host__ __device__ __forceinline__ int perm32(int rho) { const int n = rho >> 4, i = rho & 15; return 8 * (i >> 2) + 4 * n + (i & 3); }

struct Unit { int pm, pn; };
struct Gemm { const bf16_t* A; const bf16_t* Bt; int M, N, K; };

struct StaticOrder {
    int nM, nN, nwg, G, c;
    __host__ __device__ void init(int M, int N, int G_, int c_) { nM = M / BM; nN = N / BM; nwg = nM * nN; G = G_; c = c_; }
    __host__ __device__ bool next(int i, Unit& u) const {
        const long L = (long)i * G + c; if (L >= nwg) return false;
        int wgid = (int)L; { const int q = nwg / NXCD, r = nwg % NXCD, xcd = wgid % NXCD, off = wgid / NXCD; wgid = (xcd < r ? xcd * (q + 1) : r * (q + 1) + (xcd - r) * q) + off; }
        const int nig = WGM * nN, gid = wgid / nig, fm = gid * WGM, gsz = (nM - fm) < WGM ? (nM - fm) : WGM;
        u.pm = fm + ((wgid % nig) % gsz); u.pn = (wgid % nig) / gsz; return true;
    }
    __device__ __forceinline__ void a_ready(const Unit&) const {}
    __device__ __forceinline__ void done(const Unit&) const {}
};


typedef float f32x2 __attribute__((ext_vector_type(2)));
typedef __bf16 bf16x2_t __attribute__((ext_vector_type(2)));
__device__ __forceinline__ unsigned cvt_pk_bf16(float lo, float hi) { f32x2 v = {lo, hi}; bf16x2_t b = __builtin_convertvector(v, bf16x2_t); return __builtin_bit_cast(unsigned, b); }

struct EpiBf16Plain {
    static constexpr bool PERM = true, AFTER_DRAIN = false;
    bf16_t* O; int ldc;
    __device__ __forceinline__ void operator()(const f32x4 (&acc)[2][2][4][2], const Unit& u, int wr, int wc, int fr, int fq) const {
        const int row0 = u.pm * BM + wr * 64 + fr; const int col0 = u.pn * BM + wc * 32 + 8 * fq;
#pragma unroll
        for (int ai = 0; ai < 2; ++ai)
#pragma unroll
            for (int m = 0; m < 4; ++m) { bf16_t* rowp = O + (size_t)(row0 + ai * HALF + m * 16) * ldc + col0;
#pragma unroll
                for (int bj = 0; bj < 2; ++bj) { const f32x4 v0 = acc[ai][bj][m][0], v1 = acc[ai][bj][m][1];
                    u32x4 w; w.x = cvt_pk_bf16(v0[0], v0[1]); w.y = cvt_pk_bf16(v0[2], v0[3]); w.z = cvt_pk_bf16(v1[0], v1[1]); w.w = cvt_pk_bf16(v1[2], v1[3]);
                    *(u32x4*)(rowp + bj * HALF) = w; } }
    }
};
struct EpiResGate {
    static constexpr bool PERM = false, AFTER_DRAIN = false;
    const float* base; float* out; int ldc; const float* gate; int gate_stride; int tiles_per_batch;
    __device__ __forceinline__ void operator()(const f32x4 (&acc)[2][2][4][2], const Unit& u, int wr, int wc, int fr, int fq) const {
        const int row0 = u.pm * BM + wr * 64 + fr, col0 = u.pn * BM + wc * 32 + 4 * fq;
        const float* gp = gate + (size_t)(u.pm / tiles_per_batch) * gate_stride + col0;
        f32x4 gv[2][2];
#pragma unroll
        for (int bj = 0; bj < 2; ++bj)
#pragma unroll
            for (int n = 0; n < 2; ++n) gv[bj][n] = *(const f32x4*)(gp + bj * HALF + n * 16);
#pragma unroll
        for (int ai = 0; ai < 2; ++ai)
#pragma unroll
            for (int m = 0; m < 4; ++m) { const size_t off = (size_t)(row0 + ai * HALF + m * 16) * ldc + col0;
#pragma unroll
                for (int bj = 0; bj < 2; ++bj)
#pragma unroll
                    for (int n = 0; n < 2; ++n) { const f32x4 bs = *(const f32x4*)(base + off + bj * HALF + n * 16);
                        *(f32x4*)(out + off + bj * HALF + n * 16) = bs + gv[bj][n] * acc[ai][bj][m][n]; } }
    }
};
__device__ __forceinline__ float silu_f(float g) { return g * __builtin_amdgcn_rcpf(1.0f + __builtin_amdgcn_exp2f(-1.4426950408889634f * g)); }
struct EpiSwiglu {
    static constexpr bool PERM = true, AFTER_DRAIN = false;
    bf16_t* O; int ldc;
    __device__ __forceinline__ void operator()(const f32x4 (&acc)[2][2][4][2], const Unit& u, int wr, int wc, int fr, int fq) const {
        const int row0 = u.pm * BM + wr * 64 + fr; const int col0 = u.pn * HALF + wc * 32 + 8 * fq;
#pragma unroll
        for (int ai = 0; ai < 2; ++ai)
#pragma unroll
            for (int m = 0; m < 4; ++m) { bf16_t* rowp = O + (size_t)(row0 + ai * HALF + m * 16) * ldc + col0;
                const f32x4 g0 = acc[ai][0][m][0], g1 = acc[ai][0][m][1], a0 = acc[ai][1][m][0], a1 = acc[ai][1][m][1];
                u32x4 w;
                w.x = cvt_pk_bf16(silu_f(g0[0]) * a0[0], silu_f(g0[1]) * a0[1]); w.y = cvt_pk_bf16(silu_f(g0[2]) * a0[2], silu_f(g0[3]) * a0[3]);
                w.z = cvt_pk_bf16(silu_f(g1[0]) * a1[0], silu_f(g1[1]) * a1[1]); w.w = cvt_pk_bf16(silu_f(g1[2]) * a1[2], silu_f(g1[3]) * a1[3]);
                *(u32x4*)rowp = w; }
    }
};
template <class Epi, class Sched, bool ALIGN_EPI = false, bool SP2 = false>
__device__ __forceinline__ void gemm_phase(PG8_LAS unsigned char* lds, const Gemm g, const Sched& S, const Epi& E) {
    const int tid = threadIdx.x, wid = __builtin_amdgcn_readfirstlane(tid >> 6), lane = tid & 63, wr = wid >> 2, wc = wid & 3, fr = lane & 15, fq = lane >> 4;
    const int K = g.K, nt = K / BK;
    unsigned voffA[2], voffB[2];
#pragma unroll
    for (int i = 0; i < 2; ++i) { int R, C; stage_rc(tid * 16 + i * 8192, R, C); const int Rb = Epi::PERM ? ((R & ~31) + perm32(R & 31)) : R;
        voffA[i] = (unsigned)(R * K + C) * 2u; voffB[i] = (unsigned)(Rb * K + C) * 2u; }
    const size_t kstep = (size_t)(BK * 2);
    const size_t hstep = (size_t)HALF * K * 2;
    const size_t tstep = 2 * hstep;
    const unsigned ldsw = (unsigned)wid * 1024u;
    const int aoff = lds_byte(wr * 64 + fr, fq * 8), boff = lds_byte(wc * 32 + fr, fq * 8);
#define PG8_SA(b, h) (((b) * 2 + (h)) * HTB)
#define PG8_SB(b, h) ((4 + (b) * 2 + (h)) * HTB)
#define PG8_STAGE(bufoff, gbase, voff) do { _Pragma("unroll") for (int _i = 0; _i < 2; ++_i) \
        __builtin_amdgcn_global_load_lds((const unsigned*)((const char*)(gbase) + (voff)[_i]), (PG8_LAS unsigned*)(lds + (bufoff) + ldsw + _i * 8192), 16, 0, 0); } while (0)
#define PG8_LDA(dst, b, h) do { _Pragma("unroll") for (int m = 0; m < 4; ++m) _Pragma("unroll") for (int k = 0; k < 2; ++k) dst[m][k] = *(const PG8_LAS bf16x8*)(lds + PG8_SA(b, h) + aoff + m * 2048 + k * 1024); } while (0)
#define PG8_LDB(dst, b, h) do { _Pragma("unroll") for (int n = 0; n < 2; ++n) _Pragma("unroll") for (int k = 0; k < 2; ++k) dst[n][k] = *(const PG8_LAS bf16x8*)(lds + PG8_SB(b, h) + boff + n * 2048 + k * 1024); } while (0)
#define PG8_MMA(ai, bj, At, Bt) do { __builtin_amdgcn_s_setprio(1); _Pragma("unroll") for (int m = 0; m < 4; ++m) _Pragma("unroll") for (int n = 0; n < 2; ++n) _Pragma("unroll") for (int k = 0; k < 2; ++k) \
        acc[ai][bj][m][n] = __builtin_amdgcn_mfma_f32_16x16x32_bf16(Bt[n][k], At[m][k], acc[ai][bj][m][n], 0, 0, 0); __builtin_amdgcn_s_setprio(0); } while (0)
#define PG8_WAIT_V(n) asm volatile("s_waitcnt vmcnt(" #n ")" ::: "memory")
#define PG8_WAIT_L(n) asm volatile("s_waitcnt lgkmcnt(" #n ")" ::: "memory")
#define PG8_BAR __builtin_amdgcn_s_barrier()
#define PG8_SCHED __builtin_amdgcn_sched_barrier(0)
    Unit cur, nxt; int ui = 0;
    if (!S.next(0, cur)) return;
    f32x4 acc[2][2][4][2];
#pragma unroll
    for (int a = 0; a < 2; ++a)
#pragma unroll
        for (int b = 0; b < 2; ++b)
#pragma unroll
            for (int m = 0; m < 4; ++m)
#pragma unroll
                for (int n = 0; n < 2; ++n) acc[a][b][m][n] = (f32x4){0.f, 0.f, 0.f, 0.f};
    bf16x8 At[4][2], B0[2][2], B1[2][2];
    const char* cA = (const char*)g.A + (size_t)cur.pm * tstep; const char* cB = (const char*)g.Bt + (size_t)cur.pn * tstep;
    S.a_ready(cur);
    if constexpr (SP2) {
        PG8_STAGE(PG8_SB(0, 0), cB, voffB); PG8_STAGE(PG8_SB(0, 1), cB + hstep, voffB); PG8_STAGE(PG8_SA(0, 0), cA, voffA); PG8_STAGE(PG8_SA(0, 1), cA + hstep, voffA);
        if (wr == 1) PG8_BAR;
        PG8_WAIT_V(2); PG8_BAR;
        PG8_STAGE(PG8_SB(1, 0), cB + kstep, voffB); PG8_STAGE(PG8_SA(1, 0), cA + kstep, voffA); PG8_STAGE(PG8_SB(1, 1), cB + hstep + kstep, voffB);
        PG8_WAIT_V(6); PG8_BAR;
    } else {
        PG8_STAGE(PG8_SB(0, 0), cB, voffB); PG8_STAGE(PG8_SA(0, 0), cA, voffA); PG8_STAGE(PG8_SB(0, 1), cB + hstep, voffB); PG8_STAGE(PG8_SA(0, 1), cA + hstep, voffA);
        if (wr == 1) PG8_BAR;
        PG8_WAIT_V(4); PG8_BAR;
        PG8_STAGE(PG8_SB(1, 0), cB + kstep, voffB); PG8_STAGE(PG8_SA(1, 0), cA + kstep, voffA); PG8_STAGE(PG8_SB(1, 1), cB + hstep + kstep, voffB);
        PG8_WAIT_V(6); PG8_BAR;
    }
    for (;;) {
        const bool has_next = S.next(ui + 1, nxt);
        const char* nA = has_next ? (const char*)g.A + (size_t)nxt.pm * tstep : cA; const char* nB = has_next ? (const char*)g.Bt + (size_t)nxt.pn * tstep : cB;
        for (int t = 0; t < nt; t += 2) {
            const bool last = (t == nt - 2);
            const char* a1 = cA + (size_t)(t + 1) * kstep;
            const char* a2 = last ? nA : cA + (size_t)(t + 2) * kstep; const char* b2 = last ? nB : cB + (size_t)(t + 2) * kstep;
            const char* a3 = a2 + kstep; const char* b3 = b2 + kstep;
            if (last && has_next) S.a_ready(nxt);
            if constexpr (SP2) {
            PG8_LDB(B0, 0, 0); PG8_LDB(B1, 0, 1); PG8_SCHED; PG8_LDA(At, 0, 0); PG8_STAGE(PG8_SA(1, 1), a1 + hstep, voffA);
            PG8_WAIT_V(8); PG8_WAIT_L(0); PG8_BAR; PG8_MMA(0, 0, At, B0); PG8_MMA(0, 1, At, B1); PG8_BAR; PG8_SCHED;
            PG8_LDA(At, 0, 1); PG8_STAGE(PG8_SB(0, 0), b2, voffB); PG8_STAGE(PG8_SB(0, 1), b2 + hstep, voffB); PG8_STAGE(PG8_SA(0, 0), a2, voffA);
            PG8_WAIT_V(8); PG8_WAIT_L(0); PG8_BAR; PG8_MMA(1, 0, At, B0); PG8_MMA(1, 1, At, B1); PG8_BAR; PG8_SCHED;
            PG8_LDB(B0, 1, 0); PG8_LDB(B1, 1, 1); PG8_SCHED; PG8_LDA(At, 1, 0); PG8_STAGE(PG8_SA(0, 1), a2 + hstep, voffA);
            PG8_WAIT_V(8); PG8_WAIT_L(0); PG8_BAR; PG8_MMA(0, 0, At, B0); PG8_MMA(0, 1, At, B1); PG8_BAR; PG8_SCHED;
            PG8_LDA(At, 1, 1); PG8_STAGE(PG8_SB(1, 0), b3, voffB); PG8_STAGE(PG8_SB(1, 1), b3 + hstep, voffB); PG8_STAGE(PG8_SA(1, 0), a3, voffA);
            PG8_WAIT_V(8); PG8_WAIT_L(0); PG8_BAR; PG8_MMA(1, 0, At, B0); PG8_MMA(1, 1, At, B1); PG8_BAR; PG8_SCHED;
            } else {
            PG8_LDB(B0, 0, 0); PG8_SCHED; PG8_LDA(At, 0, 0); PG8_STAGE(PG8_SA(1, 1), a1 + hstep, voffA);
            PG8_WAIT_L(8); PG8_BAR; PG8_WAIT_L(0); PG8_MMA(0, 0, At, B0); PG8_BAR; PG8_SCHED;
            PG8_LDB(B1, 0, 1); PG8_STAGE(PG8_SB(0, 0), b2, voffB);
            PG8_BAR; PG8_WAIT_L(0); PG8_MMA(0, 1, At, B1); PG8_BAR;
            PG8_LDA(At, 0, 1); PG8_STAGE(PG8_SA(0, 0), a2, voffA);
            PG8_BAR; PG8_WAIT_L(0); PG8_MMA(1, 0, At, B0); PG8_BAR; PG8_SCHED;
            PG8_STAGE(PG8_SB(0, 1), b2 + hstep, voffB);
            PG8_WAIT_V(6); PG8_BAR; PG8_MMA(1, 1, At, B1); PG8_BAR;
            PG8_LDB(B0, 1, 0); PG8_SCHED; PG8_LDA(At, 1, 0); PG8_STAGE(PG8_SA(0, 1), a2 + hstep, voffA);
            PG8_WAIT_L(8); PG8_BAR; PG8_WAIT_L(0); PG8_MMA(0, 0, At, B0); PG8_BAR; PG8_SCHED;
            PG8_LDB(B1, 1, 1); PG8_STAGE(PG8_SB(1, 0), b3, voffB);
            PG8_BAR; PG8_WAIT_L(0); PG8_MMA(0, 1, At, B1); PG8_BAR;
            PG8_LDA(At, 1, 1); PG8_STAGE(PG8_SA(1, 0), a3, voffA);
            PG8_BAR; PG8_WAIT_L(0); PG8_MMA(1, 0, At, B0); PG8_BAR; PG8_SCHED;
            PG8_STAGE(PG8_SB(1, 1), b3 + hstep, voffB);
            PG8_WAIT_V(6); PG8_BAR; PG8_MMA(1, 1, At, B1); PG8_BAR;
            }
        }
        if constexpr (ALIGN_EPI) { if (wr == 0) PG8_BAR; }
        if constexpr (!Epi::AFTER_DRAIN) { E(acc, cur, wr, wc, fr, fq); S.done(cur); }
        if (!has_next) break;
#pragma unroll
        for (int a = 0; a < 2; ++a)
#pragma unroll
            for (int b = 0; b < 2; ++b)
#pragma unroll
                for (int m = 0; m < 4; ++m)
#pragma unroll
                    for (int n = 0; n < 2; ++n) acc[a][b][m][n] = (f32x4){0.f, 0.f, 0.f, 0.f};
        cur = nxt; cA = nA; cB = nB; ++ui;
        if constexpr (ALIGN_EPI) { if (wr == 1) PG8_BAR; }
    }
    PG8_WAIT_V(0);
    if constexpr (!ALIGN_EPI) { if (wr == 0) PG8_BAR; }
    PG8_BAR;
    if constexpr (Epi::AFTER_DRAIN) { E.fused(acc, cur, wr, wc, fr, fq, lds, wid, lane); S.done(cur); }
#undef PG8_SA
#undef PG8_SB
#undef PG8_STAGE
#undef PG8_LDA
#undef PG8_LDB
#undef PG8_MMA
#undef PG8_WAIT_V
#undef PG8_WAIT_L
#undef PG8_BAR
#undef PG8_SCHED
}
}

constexpr int NWAVES = 8, NTHR = NWAVES * 64;
constexpr int DM = 1024, NB = 16, SEQ = 2048, CTXL = 256;
constexpr int ML = NB * SEQ;
constexpr int MC = NB * CTXL;
constexpr int MT = ML + MC;
constexpr int NP = 2048;
constexpr int INW = 2064;
constexpr int DFF = 2816;
constexpr int NHEAD = 4, DK = 64, DV = 128;
constexpr float EPS = 1e-6f;
constexpr int NMOD = 6 * DM;
constexpr int ADA_KB = 16;

constexpr size_t MiB = 1u << 20;
constexpr size_t WS_CTL = 0;
constexpr size_t WS_MODP = 1 * MiB;
constexpr size_t WS_MOD = 8 * MiB;
constexpr size_t WS_WG = 9 * MiB;
constexpr size_t WS_POOLW = 9 * MiB + 512 * 1024;
constexpr size_t WS_WIN = 10 * MiB;
constexpr size_t WS_WOUT = 14 * MiB;
constexpr size_t WS_WUP = 16 * MiB;
constexpr size_t WS_WDN = 27 * MiB;
constexpr size_t WS_GATES = 33 * MiB;
constexpr size_t WS_HX = 36 * MiB;
constexpr size_t WS_P = 108 * MiB;
constexpr size_t WS_QK = 252 * MiB;
constexpr size_t WS_HID = WS_P;
constexpr size_t WS_MIX = 288 * MiB;
constexpr size_t WS_HF = 352 * MiB;
constexpr size_t WS_HB = 416 * MiB;
constexpr size_t WS_END = 480 * MiB;
static_assert(WS_HID + (size_t)ML * DFF * 2 <= WS_MIX, "hidden overlay");

constexpr int LDS_BYTES = 147456;
constexpr int RING_BYTES = 131072;

#define GAS __attribute__((address_space(1)))
#define LAS __attribute__((address_space(3)))
typedef unsigned short bf16;
typedef float f32x4 __attribute__((ext_vector_type(4)));
typedef float f32x2 __attribute__((ext_vector_type(2)));
typedef unsigned u32x4 __attribute__((ext_vector_type(4)));
typedef unsigned u32x2 __attribute__((ext_vector_type(2)));
#define LDS_WAIT() asm volatile("s_waitcnt lgkmcnt(0)" ::: "memory")

__device__ __forceinline__ float bf2f(unsigned short b) { return __uint_as_float((unsigned)b << 16); }
__device__ __forceinline__ float bflo(unsigned w) { return __uint_as_float(w << 16); }
__device__ __forceinline__ float bfhi(unsigned w) { return __uint_as_float(w & 0xffff0000u); }
__device__ __forceinline__ unsigned pk2(float lo, float hi) { return pg8::cvt_pk_bf16(lo, hi); }
__device__ __forceinline__ float wave_sum(float v) {
#pragma unroll
    for (int o = 1; o < 64; o <<= 1) v += __shfl_xor(v, o);
    return v;
}
__device__ __forceinline__ float silu_acc(float x) { return x / (1.0f + __expf(-x)); }

struct Args {
    const float *x, *c, *ctx, *c_ctx, *w_ada, *b_ada, *norm1, *w_in, *conv_qk, *gate_bias, *pool_w, *pool_scale, *head_norm, *w_out, *norm2, *w_up, *w_down, *norm_f;
    float* out; unsigned char* ws; int ph_lo, ph_hi;
};

__device__ __forceinline__ void tr_item(const float* W, int ldw, bf16* WT, int K, int k0, int n0, int drow0, LAS float* scr, int lane) {
#pragma unroll 8
    for (int i = 0; i < 32; ++i) { const int kk = 2 * i + (lane >> 5); scr[kk * 33 + (lane & 31)] = W[(size_t)(k0 + kk) * ldw + n0 + (lane & 31)]; }
    LDS_WAIT(); asm volatile("" ::: "memory");
    const int c = lane & 7;
#pragma unroll
    for (int j = 0; j < 4; ++j) { const int n = (lane >> 3) + 8 * j; const LAS float* s = scr + (8 * c) * 33 + n;
        u32x4 o; o.x = pk2(s[0 * 33], s[1 * 33]); o.y = pk2(s[2 * 33], s[3 * 33]); o.z = pk2(s[4 * 33], s[5 * 33]); o.w = pk2(s[6 * 33], s[7 * 33]);
        *(u32x4*)(WT + (size_t)(drow0 + n) * K + k0 + 8 * c) = o; }
    LDS_WAIT(); asm volatile("" ::: "memory");
}
__device__ __forceinline__ void phase0(const Args& a, LAS unsigned char* lds, int G) {
    const int tid = threadIdx.x, lane = tid & 63, wave = __builtin_amdgcn_readfirstlane(tid >> 6);
    LAS float* scr = (LAS float*)(lds + wave * 16384);
    const int gw = blockIdx.x * NWAVES + wave, NGW = G * NWAVES;
    unsigned char* ws = a.ws;
    bf16* win_t = (bf16*)(ws + WS_WIN); bf16* wout_t = (bf16*)(ws + WS_WOUT); bf16* wup_t = (bf16*)(ws + WS_WUP); bf16* wdn_t = (bf16*)(ws + WS_WDN); bf16* poolw_t = (bf16*)(ws + WS_POOLW);
    constexpr int I_IN = 16 * 64, I_OUT = 16 * 32, I_UP = 16 * 176, I_DN = 44 * 32, I_PW = 32, I_ADA = 24 * ADA_KB;
    constexpr int NITEMS = I_ADA + I_IN + I_OUT + I_UP + I_DN + I_PW;
    for (int it = gw; it < NITEMS; it += NGW) {
        int r = it;
        if (r < I_ADA) {
            const int cb = r / ADA_KB, kb = r % ADA_KB, k0 = kb * 64, col = cb * 256 + lane * 4;
            for (int idx = lane; idx < 17 * 64; idx += 64) { const int rr = idx >> 6, kk = idx & 63; const float cv = rr < 16 ? a.c[rr * DM + k0 + kk] : a.c_ctx[k0 + kk]; scr[idx] = silu_acc(cv); }
            LDS_WAIT(); asm volatile("" ::: "memory");
            f32x4 acc[17];
#pragma unroll
            for (int rr = 0; rr < 17; ++rr) acc[rr] = (f32x4){0.f, 0.f, 0.f, 0.f};
            for (int kk = 0; kk < 64; ++kk) { const f32x4 w = *(const f32x4*)(a.w_ada + (size_t)(k0 + kk) * NMOD + col);
#pragma unroll
                for (int rr = 0; rr < 17; ++rr) acc[rr] += scr[rr * 64 + kk] * w; }
            if (kb == 0) { const f32x4 bv = *(const f32x4*)(a.b_ada + col);
#pragma unroll
                for (int rr = 0; rr < 17; ++rr) acc[rr] += bv; }
            float* mp = (float*)(ws + WS_MODP) + (size_t)kb * 17 * NMOD + col;
#pragma unroll
            for (int rr = 0; rr < 17; ++rr) *(f32x4*)(mp + (size_t)rr * NMOD) = acc[rr];
            LDS_WAIT(); asm volatile("" ::: "memory");
            continue; }
        r -= I_ADA;
        if (r < I_IN) { const int kb = r / 64, nb = r % 64; tr_item(a.w_in, INW, win_t, DM, kb * 64, nb * 32, nb * 32, scr, lane); continue; } r -= I_IN;
        if (r < I_OUT) { const int kb = r / 32, nb = r % 32; tr_item(a.w_out, DM, wout_t, DM, kb * 64, nb * 32, nb * 32, scr, lane); continue; } r -= I_OUT;
        if (r < I_UP) { const int kb = r / 176, nb = r % 176; const int c0 = nb * 32; int drow0;
            if (c0 < DFF) drow0 = 256 * (c0 / 128) + (c0 % 128); else { const int c1 = c0 - DFF; drow0 = 256 * (c1 / 128) + 128 + (c1 % 128); }
            tr_item(a.w_up, 2 * DFF, wup_t, DM, kb * 64, c0, drow0, scr, lane); continue; } r -= I_UP;
        if (r < I_DN) { const int kb = r / 32, nb = r % 32; tr_item(a.w_down, DM, wdn_t, DFF, kb * 64, nb * 32, nb * 32, scr, lane); continue; } r -= I_DN;
        { const int g = r / 8, q = r % 8, kb = q / 4, nb = q % 4; tr_item(a.pool_w + g * 16384, 128, poolw_t + g * 16384, 128, kb * 64, nb * 32, nb * 32, scr, lane); }
    }
    float* wg = (float*)(ws + WS_WG);
    for (int idx = blockIdx.x * NTHR + tid; idx < 16 * DM; idx += G * NTHR) { const int k = idx >> 4, j = idx & 15; wg[j * DM + k] = a.w_in[(size_t)k * INW + 2048 + j]; }
}

__device__ __forceinline__ float logsigmoid_f(float v) { return fminf(v, 0.f) - log1pf(__expf(-fabsf(v))); }
__device__ __forceinline__ float reduce16(float (&v)[16], int lane) {
    { const bool up = (lane & 32) != 0;
#pragma unroll
      for (int j = 0; j < 8; ++j) { const float send = up ? v[j] : v[j + 8]; const float keep = up ? v[j + 8] : v[j]; v[j] = keep + __shfl_xor(send, 32); } }
    { const bool up = (lane & 16) != 0;
#pragma unroll
      for (int j = 0; j < 4; ++j) { const float send = up ? v[j] : v[j + 4]; const float keep = up ? v[j + 4] : v[j]; v[j] = keep + __shfl_xor(send, 16); } }
    { const bool up = (lane & 8) != 0;
#pragma unroll
      for (int j = 0; j < 2; ++j) { const float send = up ? v[j] : v[j + 2]; const float keep = up ? v[j + 2] : v[j]; v[j] = keep + __shfl_xor(send, 8); } }
    { const bool up = (lane & 4) != 0; const float send = up ? v[0] : v[1]; const float keep = up ? v[1] : v[0]; v[0] = keep + __shfl_xor(send, 4); }
    float s = v[0]; s += __shfl_xor(s, 1); s += __shfl_xor(s, 2); return s;
}
__device__ __forceinline__ void p1_pair(const Args& a, const float* xr0, const float* xr1, int orow0, int orow1, const LAS float* S, const LAS float* H, const LAS float* WgL, int lane) {
    bf16* hx = (bf16*)(a.ws + WS_HX); float* gates = (float*)(a.ws + WS_GATES);
    float s0 = 0.f, s1 = 0.f;
#pragma unroll
    for (int j = 0; j < 4; ++j) { const f32x4 v0 = *(const f32x4*)(xr0 + 4 * lane + 256 * j), v1 = *(const f32x4*)(xr1 + 4 * lane + 256 * j);
        s0 += (v0.x * v0.x + v0.y * v0.y) + (v0.z * v0.z + v0.w * v0.w); s1 += (v1.x * v1.x + v1.y * v1.y) + (v1.z * v1.z + v1.w * v1.w); }
    const float r0 = rsqrtf(wave_sum(s0) * (1.f / DM) + EPS), r1 = rsqrtf(wave_sum(s1) * (1.f / DM) + EPS);
    float g0[16], g1[16];
#pragma unroll
    for (int g = 0; g < 16; ++g) { g0[g] = 0.f; g1[g] = 0.f; }
#pragma unroll 1
    for (int j = 0; j < 4; ++j) { const int k = 4 * lane + 256 * j;
        const f32x4 v0 = *(const f32x4*)(xr0 + k), v1 = *(const f32x4*)(xr1 + k);
        const f32x4 sv = *(const LAS f32x4*)(S + k), hv = *(const LAS f32x4*)(H + k);
        const f32x4 h0 = (v0 * r0) * sv + hv, h1 = (v1 * r1) * sv + hv;
        u32x2 w0, w1; w0.x = pk2(h0.x, h0.y); w0.y = pk2(h0.z, h0.w); w1.x = pk2(h1.x, h1.y); w1.y = pk2(h1.z, h1.w);
        *(u32x2*)(hx + (size_t)orow0 * DM + k) = w0; *(u32x2*)(hx + (size_t)orow1 * DM + k) = w1;
#pragma unroll
        for (int g = 0; g < 16; ++g) { const f32x4 wv = *(const LAS f32x4*)(WgL + g * DM + k);
            g0[g] += (h0.x * wv.x + h0.y * wv.y) + (h0.z * wv.z + h0.w * wv.w); g1[g] += (h1.x * wv.x + h1.y * wv.y) + (h1.z * wv.z + h1.w * wv.w); } }
    const float t0 = reduce16(g0, lane), t1 = reduce16(g1, lane);
    if ((lane & 3) == 0) { const int g = ((lane >> 5) & 1) * 8 + ((lane >> 4) & 1) * 4 + ((lane >> 3) & 1) * 2 + ((lane >> 2) & 1);
        const float bias = a.gate_bias[g]; float y0 = t0 + bias, y1 = t1 + bias;
        if (g >= 8) { y0 = logsigmoid_f(y0); y1 = logsigmoid_f(y1); }
        gates[(size_t)orow0 * 16 + g] = y0; gates[(size_t)orow1 * 16 + g] = y1; }
}
__device__ __forceinline__ void phase1(const Args& a, LAS unsigned char* lds, int G) {
    const int tid = threadIdx.x, lane = tid & 63, wave = __builtin_amdgcn_readfirstlane(tid >> 6);
    LAS float* S1 = (LAS float*)lds; LAS float* H1 = S1 + DM; LAS float* S1c = H1 + DM; LAS float* H1c = S1c + DM; LAS float* WgL = H1c + DM;
    const float* modp = (const float*)(a.ws + WS_MODP); float* mod = (float*)(a.ws + WS_MOD); const float* wg = (const float*)(a.ws + WS_WG);
    for (int rg = blockIdx.x; rg < 256; rg += G) {
        const int b = rg >> 4, sub = rg & 15;
        __syncthreads();
#pragma unroll 1
        for (int idx = tid; idx < DM; idx += NTHR) { float sh = 0.f, sc = 0.f, shc = 0.f, scc = 0.f;
#pragma unroll 4
            for (int kb = 0; kb < ADA_KB; ++kb) { const float* p = modp + (size_t)kb * 17 * NMOD; sh += p[b * NMOD + idx]; sc += p[b * NMOD + DM + idx]; shc += p[16 * NMOD + idx]; scc += p[16 * NMOD + DM + idx]; }
            const float n1 = a.norm1[idx]; S1[idx] = n1 * (1.f + sc); H1[idx] = sh; S1c[idx] = n1 * (1.f + scc); H1c[idx] = shc; }
        if (sub == 0)
#pragma unroll 1
          for (int idx = tid; idx < NMOD; idx += NTHR) { float s = 0.f;
#pragma unroll 4
            for (int kb = 0; kb < ADA_KB; ++kb) s += modp[(size_t)kb * 17 * NMOD + b * NMOD + idx]; mod[b * NMOD + idx] = s; }
#pragma unroll 2
        for (int idx = tid; idx < 16 * DM / 4; idx += NTHR) *(LAS f32x4*)(WgL + 4 * idx) = *(const f32x4*)(wg + 4 * idx);
        __syncthreads();
        const int lr0 = b * SEQ + sub * 128 + wave * 16;
#pragma unroll 1
        for (int i = 0; i < 16; i += 2) p1_pair(a, a.x + (size_t)(lr0 + i) * DM, a.x + (size_t)(lr0 + i + 1) * DM, lr0 + i, lr0 + i + 1, S1, H1, WgL, lane);
        const int cr0 = b * CTXL + sub * 16 + wave * 2;
        p1_pair(a, a.ctx + (size_t)cr0 * DM, a.ctx + (size_t)(cr0 + 1) * DM, ML + cr0, ML + cr0 + 1, S1c, H1c, WgL, lane);
    }
}

__device__ __forceinline__ void phase2b(const Args& a, int G) {
    const int tid = threadIdx.x, lane = tid & 63, wave = __builtin_amdgcn_readfirstlane(tid >> 6);
    const int gw = blockIdx.x * NWAVES + wave, NGW = G * NWAVES;
    const bf16* P = (const bf16*)(a.ws + WS_P); bf16* QK = (bf16*)(a.ws + WS_QK);
    const int c0 = lane * 8;
    float w0[8], w1[8], w2[8];
#pragma unroll
    for (int e = 0; e < 8; ++e) { w0[e] = a.conv_qk[c0 + e]; w1[e] = a.conv_qk[512 + c0 + e]; w2[e] = a.conv_qk[1024 + c0 + e]; }
    const float qs = (c0 < 256) ? 0.125f : 1.0f;
    for (int it = gw; it < MT / 16; it += NGW) {
        const int r0 = it * 16;
        const int t0 = (r0 < ML) ? (r0 % SEQ) : ((r0 - ML) % CTXL); const int tlen = (r0 < ML) ? SEQ : CTXL;
        u32x4 prev = (u32x4){0u, 0u, 0u, 0u}, cur, nxt;
        if (t0 != 0) prev = *(const u32x4*)(P + (size_t)(r0 - 1) * NP + 512 + c0);
        cur = *(const u32x4*)(P + (size_t)r0 * NP + 512 + c0);
        for (int i = 0; i < 16; ++i) {
            const bool has_next = (i < 15) || (t0 + 16 != tlen);
            nxt = (u32x4){0u, 0u, 0u, 0u};
            if (has_next) nxt = *(const u32x4*)(P + (size_t)(r0 + i + 1) * NP + 512 + c0);
            float y[8];
#pragma unroll
            for (int e = 0; e < 4; ++e) {
                y[2 * e] = w0[2 * e] * bflo(prev[e]) + w1[2 * e] * bflo(cur[e]) + w2[2 * e] * bflo(nxt[e]);
                y[2 * e + 1] = w0[2 * e + 1] * bfhi(prev[e]) + w1[2 * e + 1] * bfhi(cur[e]) + w2[2 * e + 1] * bfhi(nxt[e]); }
            u32x4 o;
#pragma unroll
            for (int e = 0; e < 4; ++e) o[e] = pk2(silu_acc(y[2 * e]) * qs, silu_acc(y[2 * e + 1]) * qs);
            *(u32x4*)(QK + (size_t)(r0 + i) * 512 + c0) = o;
            prev = cur; cur = nxt;
        }
    }
}

__device__ __forceinline__ void phase3_pool(const Args& a, LAS unsigned char* lds, int G) {
    const int tid = threadIdx.x;
    const bf16* P = (const bf16*)(a.ws + WS_P); bf16* MIX = (bf16*)(a.ws + WS_MIX);
    LAS float* dS = (LAS float*)lds;
    for (int it = blockIdx.x; it < (ML / 64) * 4; it += G) {
        const int tb = it >> 2, g = it & 3, tok0 = tb * 64, half = 1 << g;
        __syncthreads();
        for (int i = 0; i < 16; ++i) { const int idx = tid + NTHR * i, p = idx >> 7, c = idx & 127;
            int lo = p - half; if (lo < 0) lo = 0; int hi = p + half - 1; if (hi > 63) hi = 63;
            float s = 0.f; for (int q = lo; q <= hi; ++q) s += bf2f(P[(size_t)(tok0 + q) * NP + g * 128 + c]);
            dS[p * 128 + c] = s / (float)(hi - lo + 1) - bf2f(P[(size_t)(tok0 + p) * NP + g * 128 + c]); }
        __syncthreads();
        const int n = tid & 127, pq = tid >> 7;
        float acc[16];
#pragma unroll
        for (int i = 0; i < 16; ++i) acc[i] = 0.f;
        const float* W = a.pool_w + g * 16384 + n;
        for (int c = 0; c < 128; ++c) { const float w = W[c * 128];
#pragma unroll
            for (int i = 0; i < 16; ++i) acc[i] += dS[(pq + 4 * i) * 128 + c] * w; }
        const float ps = a.pool_scale[g * 128 + n];
#pragma unroll
        for (int i = 0; i < 16; ++i) { const unsigned w = pk2(acc[i] * ps, 0.f); MIX[(size_t)(tok0 + pq + 4 * i) * DM + g * 128 + n] = (bf16)(w & 0xffffu); }
    }
}

__device__ __forceinline__ void phase3_mlstm(const Args& a, LAS unsigned char* lds, int G) {
    const int tid = threadIdx.x;
    const bf16* P = (const bf16*)(a.ws + WS_P); const bf16* QK = (const bf16*)(a.ws + WS_QK); const float* gates = (const float*)(a.ws + WS_GATES);
    LAS float* qS = (LAS float*)lds; LAS float* kS = qS + 64 * 64; LAS float* vS = kS + 64 * 64; LAS float* igS = vS + 64 * 128; LAS float* lfS = igS + 64;
    const int v = tid >> 2, dq = tid & 3;
    for (int it = blockIdx.x; it < NB * NHEAD * 2; it += G) {
        const int dir = it & 1, hh = (it >> 1) & 3, b = it >> 3;
        float* H = (float*)(a.ws + (dir ? WS_HB : WS_HF));
        float C[16], nn[16]; float m = 0.f;
#pragma unroll
        for (int d = 0; d < 16; ++d) { C[d] = 0.f; nn[d] = 0.f; }
        for (int seg = 0; seg < 2; ++seg) {
            const int tlen = seg ? SEQ : CTXL; const int rbase = seg ? b * SEQ : ML + b * CTXL;
            for (int ch = 0; ch < tlen / 64; ++ch) {
                __syncthreads();
                for (int i = 0; i < 4; ++i) { const int idx = tid + NTHR * i, jj = idx >> 5, cix = idx & 31;
                    const int st = ch * 64 + jj, t = dir ? (tlen - 1 - st) : st; const size_t row = (size_t)(rbase + t);
                    const bf16* src; LAS float* dst;
                    if (cix < 8) { src = QK + row * 512 + hh * 64 + cix * 8; dst = qS + jj * 64 + cix * 8; }
                    else if (cix < 16) { src = QK + row * 512 + 256 + hh * 64 + (cix - 8) * 8; dst = kS + jj * 64 + (cix - 8) * 8; }
                    else { src = P + row * NP + 1024 + hh * 128 + (cix - 16) * 8; dst = vS + jj * 128 + (cix - 16) * 8; }
                    const u32x4 w = *(const u32x4*)src;
#pragma unroll
                    for (int e = 0; e < 4; ++e) { dst[2 * e] = bflo(w[e]); dst[2 * e + 1] = bfhi(w[e]); } }
                if (tid < 64) { const int st = ch * 64 + tid, t = dir ? (tlen - 1 - st) : st; const size_t row = (size_t)(rbase + t);
                    igS[tid] = gates[row * 16 + dir * 4 + hh]; lfS[tid] = gates[row * 16 + 8 + dir * 4 + hh]; }
                __syncthreads();
                for (int jj = 0; jj < 64; ++jj) {
                    const float ig = igS[jj], lf = lfS[jj];
                    const float mn = fmaxf(lf + m, ig), fd = __expf(lf + m - mn), iw = __expf(ig - mn); m = mn;
                    const float vv = vS[jj * 128 + v] * iw;
                    float num = 0.f, den = 0.f;
#pragma unroll
                    for (int d4 = 0; d4 < 4; ++d4) { const f32x4 kk = *(const LAS f32x4*)(kS + jj * 64 + dq * 16 + d4 * 4), qq = *(const LAS f32x4*)(qS + jj * 64 + dq * 16 + d4 * 4);
#pragma unroll
                        for (int e = 0; e < 4; ++e) { const int d = d4 * 4 + e; C[d] = fd * C[d] + vv * kk[e]; nn[d] = fd * nn[d] + iw * kk[e]; num += C[d] * qq[e]; den += nn[d] * qq[e]; } }
                    num += __shfl_xor(num, 1); num += __shfl_xor(num, 2); den += __shfl_xor(den, 1); den += __shfl_xor(den, 2);
                    if (seg && dq == 0) { const int st = ch * 64 + jj, t = dir ? (tlen - 1 - st) : st;
                        H[(size_t)(rbase + t) * 512 + hh * 128 + v] = num / fmaxf(fabsf(den), __expf(-m)); }
                }
            }
        }
    }
}

__device__ __forceinline__ void phase4(const Args& a, int G) {
    const int tid = threadIdx.x, lane = tid & 63, wave = __builtin_amdgcn_readfirstlane(tid >> 6);
    const int gw = blockIdx.x * NWAVES + wave, NGW = G * NWAVES;
    const bf16* P = (const bf16*)(a.ws + WS_P); bf16* MIX = (bf16*)(a.ws + WS_MIX); const float* HF = (const float*)(a.ws + WS_HF); const float* HB = (const float*)(a.ws + WS_HB);
    const int c0 = lane * 8;
    float hn[8];
#pragma unroll
    for (int e = 0; e < 8; ++e) hn[e] = a.head_norm[c0 + e];
    for (int row = gw; row < ML; row += NGW) {
        const f32x4 f0 = *(const f32x4*)(HF + (size_t)row * 512 + c0), f1 = *(const f32x4*)(HF + (size_t)row * 512 + c0 + 4);
        const f32x4 b0 = *(const f32x4*)(HB + (size_t)row * 512 + c0), b1 = *(const f32x4*)(HB + (size_t)row * 512 + c0 + 4);
        const u32x4 ow = *(const u32x4*)(P + (size_t)row * NP + 1536 + c0);
        float h[8];
#pragma unroll
        for (int e = 0; e < 4; ++e) { h[e] = f0[e] + b0[e]; h[4 + e] = f1[e] + b1[e]; }
        float ss = 0.f;
#pragma unroll
        for (int e = 0; e < 8; ++e) ss += h[e] * h[e];
        ss += __shfl_xor(ss, 1); ss += __shfl_xor(ss, 2); ss += __shfl_xor(ss, 4); ss += __shfl_xor(ss, 8);
        const float r = rsqrtf(ss * (1.f / DV) + EPS);
        float o[8];
#pragma unroll
        for (int e = 0; e < 4; ++e) { o[2 * e] = bflo(ow[e]); o[2 * e + 1] = bfhi(ow[e]); }
        u32x4 w;
#pragma unroll
        for (int e = 0; e < 4; ++e) { const float y0 = h[2 * e] * r * hn[2 * e] / (1.f + __expf(-o[2 * e])), y1 = h[2 * e + 1] * r * hn[2 * e + 1] / (1.f + __expf(-o[2 * e + 1])); w[e] = pk2(y0, y1); }
        *(u32x4*)(MIX + (size_t)row * DM + 512 + c0) = w;
    }
}

template <bool FINAL> __device__ __forceinline__ void phase_rownorm(const Args& a, int G) {
    const int tid = threadIdx.x, lane = tid & 63, wave = __builtin_amdgcn_readfirstlane(tid >> 6);
    const int gw = blockIdx.x * NWAVES + wave, NGW = G * NWAVES;
    const float* mod = (const float*)(a.ws + WS_MOD); bf16* h2 = (bf16*)(a.ws + WS_HX);
    for (int row = gw; row < ML; row += NGW) {
        float* xr = a.out + (size_t)row * DM;
        f32x4 v[4]; float s = 0.f;
#pragma unroll
        for (int j = 0; j < 4; ++j) { v[j] = *(const f32x4*)(xr + 4 * lane + 256 * j); s += (v[j].x * v[j].x + v[j].y * v[j].y) + (v[j].z * v[j].z + v[j].w * v[j].w); }
        const float r = rsqrtf(wave_sum(s) * (1.f / DM) + EPS);
        if (FINAL) {
#pragma unroll
            for (int j = 0; j < 4; ++j) { const f32x4 nf = *(const f32x4*)(a.norm_f + 4 * lane + 256 * j); *(f32x4*)(xr + 4 * lane + 256 * j) = (v[j] * r) * nf; }
        } else {
            const int b = row / SEQ; const float* mp = mod + (size_t)b * NMOD;
#pragma unroll
            for (int j = 0; j < 4; ++j) { const int k = 4 * lane + 256 * j; const f32x4 n2 = *(const f32x4*)(a.norm2 + k), sh = *(const f32x4*)(mp + 3 * DM + k), sc = *(const f32x4*)(mp + 4 * DM + k);
                const f32x4 h = ((v[j] * r) * n2) * (sc + 1.0f) + sh; u32x2 w; w.x = pk2(h.x, h.y); w.y = pk2(h.z, h.w); *(u32x2*)(h2 + (size_t)row * DM + k) = w; }
        }
    }
}


typedef GAS unsigned gu32;
#define RLX_AGENT __ATOMIC_RELAXED, __HIP_MEMORY_SCOPE_AGENT
constexpr int MISC_OFF = RING_BYTES + 320;
constexpr size_t CTL_ZERO_BYTES = 16384;
#define XB_TMO      128
#define XB_XCNT(j)  (256  + 64 * (j))
#define XB_XSUB(j)  (1280 + 64 * (j))
#define XB_XGEN(j)  (2304 + 64 * (j))
#define XB_TOP      3328
#define XB_TOPGEN   3392
#define XCD_BAR_WORDS 3456
#define XB_SPIN_CAP (1u << 18)

__device__ __forceinline__ unsigned xb_ld(unsigned* p)              { return __hip_atomic_load(p, __ATOMIC_RELAXED, __HIP_MEMORY_SCOPE_AGENT); }
__device__ __forceinline__ unsigned xb_add(unsigned* p, unsigned v) { return __hip_atomic_fetch_add(p, v, __ATOMIC_RELAXED, __HIP_MEMORY_SCOPE_AGENT); }
__device__ __forceinline__ unsigned xb_xcc_id() { return (unsigned)__builtin_amdgcn_s_getreg((3 << 11) | 20) & 0xFu; }
#define XB_SPIN(cond, bar) do { unsigned _sp = 0; while (cond) { __builtin_amdgcn_s_sleep(1); \
    if ((++_sp & 255u) == 0u) { if (xb_ld(&(bar)[XB_TMO])) break; if (_sp > XB_SPIN_CAP) { atomicAdd(&(bar)[XB_TMO], 1u); break; } } } } while (0)

struct XcdBarrier {
    unsigned* bar; unsigned x;
    volatile LAS unsigned* st;
};

__device__ __forceinline__ XcdBarrier xcd_barrier_post(unsigned* bar, volatile LAS unsigned* st) {
    XcdBarrier b; b.bar = bar; b.x = xb_xcc_id(); b.st = st;
    if (threadIdx.x == 0) (void)xb_add(&bar[XB_XCNT(b.x)], 1u);
    return b;
}
__device__ __forceinline__ void xcd_barrier_complete(unsigned* bar, unsigned x, unsigned& nloc, unsigned& nx) {
    const unsigned G = gridDim.x * gridDim.y * gridDim.z;
    unsigned sum, cnt, mine, sp = 0u;
    for (;;) {
        sum = 0u; cnt = 0u; mine = 0u;
#pragma unroll
        for (unsigned j = 0; j < 16; ++j) { const unsigned c = xb_ld(&bar[XB_XCNT(j)]); sum += c; cnt += (c > 0u) ? 1u : 0u; mine = (j == x) ? c : mine; }
        if (sum == G) break;
        __builtin_amdgcn_s_sleep(1);
        if ((++sp & 255u) == 0u) { if (xb_ld(&bar[XB_TMO])) break; if (sp > XB_SPIN_CAP) { atomicAdd(&bar[XB_TMO], 1u); break; } }
    }
    nloc = mine > 0u ? mine : 1u; nx = cnt > 0u ? cnt : 1u;
}

__device__ __forceinline__ void xcd_barrier(const XcdBarrier& b) {
    asm volatile("s_waitcnt vmcnt(0)" ::: "memory");
    __syncthreads();
    if (threadIdx.x == 0) {
        unsigned* bar = b.bar;
        __builtin_amdgcn_s_waitcnt(0);
        unsigned nloc = b.st[0], nx = b.st[1];
        if (nloc == 0u) { xcd_barrier_complete(bar, b.x, nloc, nx); b.st[0] = nloc; b.st[1] = nx; }
        const unsigned old = xb_add(&bar[XB_XSUB(b.x)], 1u);
        const unsigned gen = old / nloc;
        if (old + 1u == (gen + 1u) * nloc) {
            __builtin_amdgcn_fence(__ATOMIC_RELEASE, "agent");
            asm volatile("s_waitcnt vmcnt(0)" ::: "memory");
            const unsigned og = xb_add(&bar[XB_TOP], 1u);
            const unsigned tg = og / nx;
            if (og + 1u == (tg + 1u) * nx) xb_add(&bar[XB_TOPGEN], 1u);
            else XB_SPIN(xb_ld(&bar[XB_TOPGEN]) == tg, bar);
            __builtin_amdgcn_fence(__ATOMIC_ACQUIRE, "agent");
            xb_add(&bar[XB_XGEN(b.x)], 1u);
            asm volatile("s_waitcnt vmcnt(0)" ::: "memory");
        } else {
            XB_SPIN(xb_ld(&bar[XB_XGEN(b.x)]) == gen, bar);
            __builtin_amdgcn_fence(__ATOMIC_ACQUIRE, "agent");
            asm volatile("s_waitcnt vmcnt(0)" ::: "memory");
        }
    }
    __syncthreads();
}

constexpr int N_PHASES = 11;
__global__ void __launch_bounds__(NTHR, 2) fwd_kernel(Args a) {
    extern __shared__ __attribute__((aligned(16))) unsigned char lds_raw[];
    LAS unsigned char* lds = (LAS unsigned char*)lds_raw;
    const int G = gridDim.x;
    const int lo = a.ph_lo, hi = a.ph_hi;
    for (int u = threadIdx.x; u < (LDS_BYTES - RING_BYTES) / 4; u += NTHR) ((LAS unsigned*)(lds + RING_BYTES))[u] = 0u;
    __syncthreads();
    XcdBarrier bar = xcd_barrier_post((unsigned*)(a.ws + WS_CTL), (volatile LAS unsigned*)(lds + MISC_OFF) + 8);
#ifndef PHASE_MASK
#define PHASE_MASK 0x7ff
#endif
#define IN(k) ((((PHASE_MASK) >> (k)) & 1) && lo <= (k) && (k) < hi)
#define SEAM(k) do { if (IN(k) && IN((k) + 1)) xcd_barrier(bar); } while (0)
    unsigned char* ws = a.ws;
    if (IN(0)) { phase0(a, lds, G); } SEAM(0);
    if (IN(1)) { phase1(a, lds, G); } SEAM(1);
    if (IN(2)) {
        pg8::Gemm g{(const bf16*)(ws + WS_HX), (const bf16*)(ws + WS_WIN), MT, NP, DM}; pg8::StaticOrder S; S.init(MT, NP, G, (int)blockIdx.x);
        pg8::EpiBf16Plain E{(bf16*)(ws + WS_P), NP};
        pg8::gemm_phase<pg8::EpiBf16Plain, pg8::StaticOrder, true, true>(lds, g, S, E);
    } SEAM(2);
    if (IN(3)) { phase2b(a, G); } SEAM(3);
    if (IN(4)) { phase3_pool(a, lds, G); phase3_mlstm(a, lds, G); } SEAM(4);
    if (IN(5)) { phase4(a, G); } SEAM(5);
    if (IN(6)) {
        pg8::Gemm g{(const bf16*)(ws + WS_MIX), (const bf16*)(ws + WS_WOUT), ML, DM, DM}; pg8::StaticOrder S; S.init(ML, DM, G, (int)blockIdx.x);
        pg8::EpiResGate E{a.x, a.out, DM, (const float*)(ws + WS_MOD) + 2 * DM, NMOD, SEQ / 256};
        pg8::gemm_phase<pg8::EpiResGate, pg8::StaticOrder, true, true>(lds, g, S, E);
    } SEAM(6);
    if (IN(7)) { phase_rownorm<false>(a, G); } SEAM(7);
    if (IN(8)) {
        pg8::Gemm g{(const bf16*)(ws + WS_HX), (const bf16*)(ws + WS_WUP), ML, 2 * DFF, DM}; pg8::StaticOrder S; S.init(ML, 2 * DFF, G, (int)blockIdx.x);
        pg8::EpiSwiglu E{(bf16*)(ws + WS_HID), DFF};
        pg8::gemm_phase<pg8::EpiSwiglu, pg8::StaticOrder, true, true>(lds, g, S, E);
    } SEAM(8);
    if (IN(9)) {
        pg8::Gemm g{(const bf16*)(ws + WS_HID), (const bf16*)(ws + WS_WDN), ML, DM, DFF}; pg8::StaticOrder S; S.init(ML, DM, G, (int)blockIdx.x);
        pg8::EpiResGate E{a.out, a.out, DM, (const float*)(ws + WS_MOD) + 5 * DM, NMOD, SEQ / 256};
        pg8::gemm_phase<pg8::EpiResGate, pg8::StaticOrder, true, true>(lds, g, S, E);
    } SEAM(9);
    if (IN(10)) { phase_rownorm<true>(a, G); }
#undef IN
#undef SEAM
}

#ifndef N_LAUNCHES
#define N_LAUNCHES 1
#endif
extern "C" void kernel_launch(void* const* d_in, const int* in_sizes, int n_in, void* d_out, int out_size, void* d_ws, size_t ws_size, hipStream_t stream) {
    static int grid = 0;
    if (grid == 0) {
        if (n_in != 18 || out_size != ML * DM || ws_size < WS_END) { fprintf(stderr, "kernel_launch: unexpected shapes (n_in %d out %d ws %zu)\n", n_in, out_size, ws_size); grid = -1; return; }
        int dev = 0, cus = 0, per_cu = 0;
        hipGetDevice(&dev); hipDeviceGetAttribute(&cus, hipDeviceAttributeMultiprocessorCount, dev);
        if (hipFuncSetAttribute((const void*)fwd_kernel, hipFuncAttributeMaxDynamicSharedMemorySize, LDS_BYTES) != hipSuccess) { fprintf(stderr, "kernel_launch: hipFuncSetAttribute failed\n"); grid = -1; return; }
        if (hipOccupancyMaxActiveBlocksPerMultiprocessor(&per_cu, (const void*)fwd_kernel, NTHR, LDS_BYTES) != hipSuccess || per_cu < 1) { fprintf(stderr, "kernel_launch: occupancy query says %d\n", per_cu); per_cu = 1; }
        (void)hipGetLastError();
        grid = cus * (per_cu > 1 ? 1 : per_cu);
        if (grid <= 0) grid = 256;
    }
    if (grid < 0) return;
    Args a{};
    a.x = (const float*)d_in[0]; a.c = (const float*)d_in[1]; a.ctx = (const float*)d_in[2]; a.c_ctx = (const float*)d_in[3]; a.w_ada = (const float*)d_in[4]; a.b_ada = (const float*)d_in[5];
    a.norm1 = (const float*)d_in[6]; a.w_in = (const float*)d_in[7]; a.conv_qk = (const float*)d_in[8]; a.gate_bias = (const float*)d_in[9]; a.pool_w = (const float*)d_in[10]; a.pool_scale = (const float*)d_in[11];
    a.head_norm = (const float*)d_in[12]; a.w_out = (const float*)d_in[13]; a.norm2 = (const float*)d_in[14]; a.w_up = (const float*)d_in[15]; a.w_down = (const float*)d_in[16]; a.norm_f = (const float*)d_in[17];
    a.out = (float*)d_out; a.ws = (unsigned char*)d_ws;
    if (hipMemsetAsync((char*)d_ws + WS_CTL, 0, CTL_ZERO_BYTES, stream) != hipSuccess) { fprintf(stderr, "kernel_launch: memset failed\n"); return; }
#if N_LAUNCHES == 1
    a.ph_lo = 0; a.ph_hi = N_PHASES;
    void* args[] = {&a};
    hipError_t e = hipLaunchCooperativeKernel((const void*)fwd_kernel, dim3(grid), dim3(NTHR), args, LDS_BYTES, stream);
    if (e != hipSuccess) fprintf(stderr, "cooperative launch failed: %s (grid %d)\n", hipGetErrorString(e), grid);
#else
    for (int p = 0; p < N_PHASES; ++p) { a.ph_lo = p; a.ph_hi = p + 1; hipLaunchKernelGGL(fwd_kernel, dim3(grid), dim3(NTHR), LDS_BYTES, stream, a); }
#endif
}
```

```cpp
#include <hip/hip_runtime.h>
#include <hip/hip_cooperative_groups.h>
#include <cstdio>
#include <cstdint>
namespace cg = cooperative_groups;
namespace pg8 {
#define PG8_LAS __attribute__((address_space(3)))
typedef unsigned short bf16_t;
typedef short bf16x8 __attribute__((ext_vector_type(8)));
typedef float f32x4 __attribute__((ext_vector_type(4)));
typedef unsigned u32x4 __attribute__((ext_vector_type(4)));
constexpr int BM = 256, BK = 64, HALF = 128, HTB = HALF * BK * 2  , STAGE_BYTES = 8 * HTB, NXCD = 8, WGM = 8;

__host__ __device__ __forceinline__ int lds_byte(int r, int c) { const int st = (r >> 4) * 2 + (c >> 5), rr = r & 15, cc = c & 31, ob = rr * 64 + cc * 2; return st * 1024 + (ob ^ (((ob >> 9) & 1) << 5)); }
__host__ __device__ __forceinline__ void stage_rc(int b, int& R, int& C) { const int st = b / 1024, sb = b % 1024, swz = sb ^ (((sb >> 9) & 1) << 5); R = (st >> 1) * 16 + swz / 64; C = (st & 1) * 32 + (swz % 64) / 2; }
__host__ __device__ __forceinline__ int perm32(int rho) { const int n = rho >> 4, i = rho & 15; return 8 * (i >> 2) + 4 * n + (i & 3); }

struct Unit { int pm, pn; };
struct Gemm { const bf16_t* A; const bf16_t* Bt; int M, N, K; };

struct StaticOrder {
    int nM, nN, nwg, G, c;
    __host__ __device__ void init(int M, int N, int G_, int c_) { nM = M / BM; nN = N / BM; nwg = nM * nN; G = G_; c = c_; }
    __host__ __device__ bool next(int i, Unit& u) const {
        const long L = (long)i * G + c; if (L >= nwg) return false;
        int wgid = (int)L; { const int q = nwg / NXCD, r = nwg % NXCD, xcd = wgid % NXCD, off = wgid / NXCD; wgid = (xcd < r ? xcd * (q + 1) : r * (q + 1) + (xcd - r) * q) + off; }
        const int nig = WGM * nN, gid = wgid / nig, fm = gid * WGM, gsz = (nM - fm) < WGM ? (nM - fm) : WGM;
        u.pm = fm + ((wgid % nig) % gsz); u.pn = (wgid % nig) / gsz; return true;
    }
    __device__ __forceinline__ void a_ready(const Unit&) const {}
    __device__ __forceinline__ void done(const Unit&) const {}
};


typedef float f32x2 __attribute__((ext_vector_type(2)));
typedef __bf16 bf16x2_t __attribute__((ext_vector_type(2)));
__device__ __forceinline__ unsigned cvt_pk_bf16(float lo, float hi) { f32x2 v = {lo, hi}; bf16x2_t b = __builtin_convertvector(v, bf16x2_t); return __builtin_bit_cast(unsigned, b); }

struct EpiBf16Plain {
    static constexpr bool PERM = true, AFTER_DRAIN = false;
    bf16_t* O; int ldc;
    __device__ __forceinline__ void operator()(const f32x4 (&acc)[2][2][4][2], const Unit& u, int wr, int wc, int fr, int fq) const {
        const int row0 = u.pm * BM + wr * 64 + fr; const int col0 = u.pn * BM + wc * 32 + 8 * fq;
#pragma unroll
        for (int ai = 0; ai < 2; ++ai)
#pragma unroll
            for (int m = 0; m < 4; ++m) { bf16_t* rowp = O + (size_t)(row0 + ai * HALF + m * 16) * ldc + col0;
#pragma unroll
                for (int bj = 0; bj < 2; ++bj) { const f32x4 v0 = acc[ai][bj][m][0], v1 = acc[ai][bj][m][1];
                    u32x4 w; w.x = cvt_pk_bf16(v0[0], v0[1]); w.y = cvt_pk_bf16(v0[2], v0[3]); w.z = cvt_pk_bf16(v1[0], v1[1]); w.w = cvt_pk_bf16(v1[2], v1[3]);
                    *(u32x4*)(rowp + bj * HALF) = w; } }
    }
};
struct EpiResGate {
    static constexpr bool PERM = false, AFTER_DRAIN = false;
    const float* base; float* out; int ldc; const float* gate; int gate_stride; int tiles_per_batch;
    __device__ __forceinline__ void operator()(const f32x4 (&acc)[2][2][4][2], const Unit& u, int wr, int wc, int fr, int fq) const {
        const int row0 = u.pm * BM + wr * 64 + fr, col0 = u.pn * BM + wc * 32 + 4 * fq;
        const float* gp = gate + (size_t)(u.pm / tiles_per_batch) * gate_stride + col0;
        f32x4 gv[2][2];
#pragma unroll
        for (int bj = 0; bj < 2; ++bj)
#pragma unroll
            for (int n = 0; n < 2; ++n) gv[bj][n] = *(const f32x4*)(gp + bj * HALF + n * 16);
#pragma unroll
        for (int ai = 0; ai < 2; ++ai)
#pragma unroll
            for (int m = 0; m < 4; ++m) { const size_t off = (size_t)(row0 + ai * HALF + m * 16) * ldc + col0;
#pragma unroll
                for (int bj = 0; bj < 2; ++bj)
#pragma unroll
                    for (int n = 0; n < 2; ++n) { const f32x4 bs = *(const f32x4*)(base + off + bj * HALF + n * 16);
                        *(f32x4*)(out + off + bj * HALF + n * 16) = bs + gv[bj][n] * acc[ai][bj][m][n]; } }
    }
};
__device__ __forceinline__ float silu_f(float g) { return g * __builtin_amdgcn_rcpf(1.0f + __builtin_amdgcn_exp2f(-1.4426950408889634f * g)); }
struct EpiSwiglu {
    static constexpr bool PERM = true, AFTER_DRAIN = false;
    bf16_t* O; int ldc;
    __device__ __forceinline__ void operator()(const f32x4 (&acc)[2][2][4][2], const Unit& u, int wr, int wc, int fr, int fq) const {
        const int row0 = u.pm * BM + wr * 64 + fr; const int col0 = u.pn * HALF + wc * 32 + 8 * fq;
#pragma unroll
        for (int ai = 0; ai < 2; ++ai)
#pragma unroll
            for (int m = 0; m < 4; ++m) { bf16_t* rowp = O + (size_t)(row0 + ai * HALF + m * 16) * ldc + col0;
                const f32x4 g0 = acc[ai][0][m][0], g1 = acc[ai][0][m][1], a0 = acc[ai][1][m][0], a1 = acc[ai][1][m][1];
                u32x4 w;
                w.x = cvt_pk_bf16(silu_f(g0[0]) * a0[0], silu_f(g0[1]) * a0[1]); w.y = cvt_pk_bf16(silu_f(g0[2]) * a0[2], silu_f(g0[3]) * a0[3]);
                w.z = cvt_pk_bf16(silu_f(g1[0]) * a1[0], silu_f(g1[1]) * a1[1]); w.w = cvt_pk_bf16(silu_f(g1[2]) * a1[2], silu_f(g1[3]) * a1[3]);
                *(u32x4*)rowp = w; }
    }
};
template <class Epi, class Sched, bool ALIGN_EPI = false, bool SP2 = false>
__device__ __forceinline__ void gemm_phase(PG8_LAS unsigned char* lds, const Gemm g, const Sched& S, const Epi& E) {
    const int tid = threadIdx.x, wid = __builtin_amdgcn_readfirstlane(tid >> 6), lane = tid & 63, wr = wid >> 2, wc = wid & 3, fr = lane & 15, fq = lane >> 4;
    const int K = g.K, nt = K / BK;
    unsigned voffA[2], voffB[2];
#pragma unroll
    for (int i = 0; i < 2; ++i) { int R, C; stage_rc(tid * 16 + i * 8192, R, C); const int Rb = Epi::PERM ? ((R & ~31) + perm32(R & 31)) : R;
        voffA[i] = (unsigned)(R * K + C) * 2u; voffB[i] = (unsigned)(Rb * K + C) * 2u; }
    const size_t kstep = (size_t)(BK * 2);
    const size_t hstep = (size_t)HALF * K * 2;
    const size_t tstep = 2 * hstep;
    const unsigned ldsw = (unsigned)wid * 1024u;
    const int aoff = lds_byte(wr * 64 + fr, fq * 8), boff = lds_byte(wc * 32 + fr, fq * 8);
#define PG8_SA(b, h) (((b) * 2 + (h)) * HTB)
#define PG8_SB(b, h) ((4 + (b) * 2 + (h)) * HTB)
#define PG8_STAGE(bufoff, gbase, voff) do { _Pragma("unroll") for (int _i = 0; _i < 2; ++_i) \
        __builtin_amdgcn_global_load_lds((const unsigned*)((const char*)(gbase) + (voff)[_i]), (PG8_LAS unsigned*)(lds + (bufoff) + ldsw + _i * 8192), 16, 0, 0); } while (0)
#define PG8_LDA(dst, b, h) do { _Pragma("unroll") for (int m = 0; m < 4; ++m) _Pragma("unroll") for (int k = 0; k < 2; ++k) dst[m][k] = *(const PG8_LAS bf16x8*)(lds + PG8_SA(b, h) + aoff + m * 2048 + k * 1024); } while (0)
#define PG8_LDB(dst, b, h) do { _Pragma("unroll") for (int n = 0; n < 2; ++n) _Pragma("unroll") for (int k = 0; k < 2; ++k) dst[n][k] = *(const PG8_LAS bf16x8*)(lds + PG8_SB(b, h) + boff + n * 2048 + k * 1024); } while (0)
#define PG8_MMA(ai, bj, At, Bt) do { __builtin_amdgcn_s_setprio(1); _Pragma("unroll") for (int m = 0; m < 4; ++m) _Pragma("unroll") for (int n = 0; n < 2; ++n) _Pragma("unroll") for (int k = 0; k < 2; ++k) \
        acc[ai][bj][m][n] = __builtin_amdgcn_mfma_f32_16x16x32_bf16(Bt[n][k], At[m][k], acc[ai][bj][m][n], 0, 0, 0); __builtin_amdgcn_s_setprio(0); } while (0)
#define PG8_WAIT_V(n) asm volatile("s_waitcnt vmcnt(" #n ")" ::: "memory")
#define PG8_WAIT_L(n) asm volatile("s_waitcnt lgkmcnt(" #n ")" ::: "memory")
#define PG8_BAR __builtin_amdgcn_s_barrier()
#define PG8_SCHED __builtin_amdgcn_sched_barrier(0)
    Unit cur, nxt; int ui = 0;
    if (!S.next(0, cur)) return;
    f32x4 acc[2][2][4][2];
#pragma unroll
    for (int a = 0; a < 2; ++a)
#pragma unroll
        for (int b = 0; b < 2; ++b)
#pragma unroll
            for (int m = 0; m < 4; ++m)
#pragma unroll
                for (int n = 0; n < 2; ++n) acc[a][b][m][n] = (f32x4){0.f, 0.f, 0.f, 0.f};
    bf16x8 At[4][2], B0[2][2], B1[2][2];
    const char* cA = (const char*)g.A + (size_t)cur.pm * tstep; const char* cB = (const char*)g.Bt + (size_t)cur.pn * tstep;
    S.a_ready(cur);
    if constexpr (SP2) {
        PG8_STAGE(PG8_SB(0, 0), cB, voffB); PG8_STAGE(PG8_SB(0, 1), cB + hstep, voffB); PG8_STAGE(PG8_SA(0, 0), cA, voffA); PG8_STAGE(PG8_SA(0, 1), cA + hstep, voffA);
        if (wr == 1) PG8_BAR;
        PG8_WAIT_V(2); PG8_BAR;
        PG8_STAGE(PG8_SB(1, 0), cB + kstep, voffB); PG8_STAGE(PG8_SA(1, 0), cA + kstep, voffA); PG8_STAGE(PG8_SB(1, 1), cB + hstep + kstep, voffB);
        PG8_WAIT_V(6); PG8_BAR;
    } else {
        PG8_STAGE(PG8_SB(0, 0), cB, voffB); PG8_STAGE(PG8_SA(0, 0), cA, voffA); PG8_STAGE(PG8_SB(0, 1), cB + hstep, voffB); PG8_STAGE(PG8_SA(0, 1), cA + hstep, voffA);
        if (wr == 1) PG8_BAR;
        PG8_WAIT_V(4); PG8_BAR;
        PG8_STAGE(PG8_SB(1, 0), cB + kstep, voffB); PG8_STAGE(PG8_SA(1, 0), cA + kstep, voffA); PG8_STAGE(PG8_SB(1, 1), cB + hstep + kstep, voffB);
        PG8_WAIT_V(6); PG8_BAR;
    }
    for (;;) {
        const bool has_next = S.next(ui + 1, nxt);
        const char* nA = has_next ? (const char*)g.A + (size_t)nxt.pm * tstep : cA; const char* nB = has_next ? (const char*)g.Bt + (size_t)nxt.pn * tstep : cB;
        for (int t = 0; t < nt; t += 2) {
            const bool last = (t == nt - 2);
            const char* a1 = cA + (size_t)(t + 1) * kstep;
            const char* a2 = last ? nA : cA + (size_t)(t + 2) * kstep; const char* b2 = last ? nB : cB + (size_t)(t + 2) * kstep;
            const char* a3 = a2 + kstep; const char* b3 = b2 + kstep;
            if (last && has_next) S.a_ready(nxt);
            if constexpr (SP2) {
            PG8_LDB(B0, 0, 0); PG8_LDB(B1, 0, 1); PG8_SCHED; PG8_LDA(At, 0, 0); PG8_STAGE(PG8_SA(1, 1), a1 + hstep, voffA);
            PG8_WAIT_V(8); PG8_WAIT_L(0); PG8_BAR; PG8_MMA(0, 0, At, B0); PG8_MMA(0, 1, At, B1); PG8_BAR; PG8_SCHED;
            PG8_LDA(At, 0, 1); PG8_STAGE(PG8_SB(0, 0), b2, voffB); PG8_STAGE(PG8_SB(0, 1), b2 + hstep, voffB); PG8_STAGE(PG8_SA(0, 0), a2, voffA);
            PG8_WAIT_V(8); PG8_WAIT_L(0); PG8_BAR; PG8_MMA(1, 0, At, B0); PG8_MMA(1, 1, At, B1); PG8_BAR; PG8_SCHED;
            PG8_LDB(B0, 1, 0); PG8_LDB(B1, 1, 1); PG8_SCHED; PG8_LDA(At, 1, 0); PG8_STAGE(PG8_SA(0, 1), a2 + hstep, voffA);
            PG8_WAIT_V(8); PG8_WAIT_L(0); PG8_BAR; PG8_MMA(0, 0, At, B0); PG8_MMA(0, 1, At, B1); PG8_BAR; PG8_SCHED;
            PG8_LDA(At, 1, 1); PG8_STAGE(PG8_SB(1, 0), b3, voffB); PG8_STAGE(PG8_SB(1, 1), b3 + hstep, voffB); PG8_STAGE(PG8_SA(1, 0), a3, voffA);
            PG8_WAIT_V(8); PG8_WAIT_L(0); PG8_BAR; PG8_MMA(1, 0, At, B0); PG8_MMA(1, 1, At, B1); PG8_BAR; PG8_SCHED;
            } else {
            PG8_LDB(B0, 0, 0); PG8_SCHED; PG8_LDA(At, 0, 0); PG8_STAGE(PG8_SA(1, 1), a1 + hstep, voffA);
            PG8_WAIT_L(8); PG8_BAR; PG8_WAIT_L(0); PG8_MMA(0, 0, At, B0); PG8_BAR; PG8_SCHED;
            PG8_LDB(B1, 0, 1); PG8_STAGE(PG8_SB(0, 0), b2, voffB);
            PG8_BAR; PG8_WAIT_L(0); PG8_MMA(0, 1, At, B1); PG8_BAR;
            PG8_LDA(At, 0, 1); PG8_STAGE(PG8_SA(0, 0), a2, voffA);
            PG8_BAR; PG8_WAIT_L(0); PG8_MMA(1, 0, At, B0); PG8_BAR; PG8_SCHED;
            PG8_STAGE(PG8_SB(0, 1), b2 + hstep, voffB);
            PG8_WAIT_V(6); PG8_BAR; PG8_MMA(1, 1, At, B1); PG8_BAR;
            PG8_LDB(B0, 1, 0); PG8_SCHED; PG8_LDA(At, 1, 0); PG8_STAGE(PG8_SA(0, 1), a2 + hstep, voffA);
            PG8_WAIT_L(8); PG8_BAR; PG8_WAIT_L(0); PG8_MMA(0, 0, At, B0); PG8_BAR; PG8_SCHED;
            PG8_LDB(B1, 1, 1); PG8_STAGE(PG8_SB(1, 0), b3, voffB);
            PG8_BAR; PG8_WAIT_L(0); PG8_MMA(0, 1, At, B1); PG8_BAR;
            PG8_LDA(At, 1, 1); PG8_STAGE(PG8_SA(1, 0), a3, voffA);
            PG8_BAR; PG8_WAIT_L(0); PG8_MMA(1, 0, At, B0); PG8_BAR; PG8_SCHED;
            PG8_STAGE(PG8_SB(1, 1), b3 + hstep, voffB);
            PG8_WAIT_V(6); PG8_BAR; PG8_MMA(1, 1, At, B1); PG8_BAR;
            }
        }
        if constexpr (ALIGN_EPI) { if (wr == 0) PG8_BAR; }
        if constexpr (!Epi::AFTER_DRAIN) { E(acc, cur, wr, wc, fr, fq); S.done(cur); }
        if (!has_next) break;
#pragma unroll
        for (int a = 0; a < 2; ++a)
#pragma unroll
            for (int b = 0; b < 2; ++b)
#pragma unroll
                for (int m = 0; m < 4; ++m)
#pragma unroll
                    for (int n = 0; n < 2; ++n) acc[a][b][m][n] = (f32x4){0.f, 0.f, 0.f, 0.f};
        cur = nxt; cA = nA; cB = nB; ++ui;
        if constexpr (ALIGN_EPI) { if (wr == 1) PG8_BAR; }
    }
    PG8_WAIT_V(0);
    if constexpr (!ALIGN_EPI) { if (wr == 0) PG8_BAR; }
    PG8_BAR;
    if constexpr (Epi::AFTER_DRAIN) { E.fused(acc, cur, wr, wc, fr, fq, lds, wid, lane); S.done(cur); }
#undef PG8_SA
#undef PG8_SB
#undef PG8_STAGE
#undef PG8_LDA
#undef PG8_LDB
#undef PG8_MMA
#undef PG8_WAIT_V
#undef PG8_WAIT_L
#undef PG8_BAR
#undef PG8_SCHED
}
}

constexpr int NWAVES = 8, NTHR = NWAVES * 64;
constexpr int DM = 1024, NB = 16, SEQ = 2048, CTXL = 256;
constexpr int ML = NB * SEQ;
constexpr int MC = NB * CTXL;
constexpr int MT = ML + MC;
constexpr int NP = 2048;
constexpr int INW = 2064;
constexpr int DFF = 2816;
constexpr int NHEAD = 4, DK = 64, DV = 128;
constexpr float EPS = 1e-6f;
constexpr int NMOD = 6 * DM;
constexpr int ADA_KB = 16;

constexpr size_t MiB = 1u << 20;
constexpr size_t WS_CTL = 0;
constexpr size_t WS_MODP = 1 * MiB;
constexpr size_t WS_MOD = 8 * MiB;
constexpr size_t WS_WG = 9 * MiB;
constexpr size_t WS_POOLW = 9 * MiB + 512 * 1024;
constexpr size_t WS_WIN = 10 * MiB;
constexpr size_t WS_WOUT = 14 * MiB;
constexpr size_t WS_WUP = 16 * MiB;
constexpr size_t WS_WDN = 27 * MiB;
constexpr size_t WS_GATES = 33 * MiB;
constexpr size_t WS_HX = 36 * MiB;
constexpr size_t WS_P = 108 * MiB;
constexpr size_t WS_QK = 252 * MiB;
constexpr size_t WS_HID = WS_P;
constexpr size_t WS_MIX = 288 * MiB;
constexpr size_t WS_HF = 352 * MiB;
constexpr size_t WS_HB = 416 * MiB;
constexpr size_t WS_END = 480 * MiB;
static_assert(WS_HID + (size_t)ML * DFF * 2 <= WS_MIX, "hidden overlay");

constexpr int LDS_BYTES = 147456;
constexpr int RING_BYTES = 131072;

#define GAS __attribute__((address_space(1)))
#define LAS __attribute__((address_space(3)))
typedef unsigned short bf16;
typedef float f32x4 __attribute__((ext_vector_type(4)));
typedef float f32x2 __attribute__((ext_vector_type(2)));
typedef unsigned u32x4 __attribute__((ext_vector_type(4)));
typedef unsigned u32x2 __attribute__((ext_vector_type(2)));
#define LDS_WAIT() asm volatile("s_waitcnt lgkmcnt(0)" ::: "memory")

__device__ __forceinline__ float bf2f(unsigned short b) { return __uint_as_float((unsigned)b << 16); }
__device__ __forceinline__ float bflo(unsigned w) { return __uint_as_float(w << 16); }
__device__ __forceinline__ float bfhi(unsigned w) { return __uint_as_float(w & 0xffff0000u); }
__device__ __forceinline__ unsigned pk2(float lo, float hi) { return pg8::cvt_pk_bf16(lo, hi); }
__device__ __forceinline__ float wave_sum(float v) {
#pragma unroll
    for (int o = 1; o < 64; o <<= 1) v += __shfl_xor(v, o);
    return v;
}
__device__ __forceinline__ float silu_acc(float x) { return x / (1.0f + __expf(-x)); }

struct Args {
    const float *x, *c, *ctx, *c_ctx, *w_ada, *b_ada, *norm1, *w_in, *conv_qk, *gate_bias, *pool_w, *pool_scale, *head_norm, *w_out, *norm2, *w_up, *w_down, *norm_f;
    float* out; unsigned char* ws; int ph_lo, ph_hi;
};

__device__ __forceinline__ void tr_item(const float* W, int ldw, bf16* WT, int K, int k0, int n0, int drow0, LAS float* scr, int lane) {
#pragma unroll 8
    for (int i = 0; i < 32; ++i) { const int kk = 2 * i + (lane >> 5); scr[kk * 33 + (lane & 31)] = W[(size_t)(k0 + kk) * ldw + n0 + (lane & 31)]; }
    LDS_WAIT(); asm volatile("" ::: "memory");
    const int c = lane & 7;
#pragma unroll
    for (int j = 0; j < 4; ++j) { const int n = (lane >> 3) + 8 * j; const LAS float* s = scr + (8 * c) * 33 + n;
        u32x4 o; o.x = pk2(s[0 * 33], s[1 * 33]); o.y = pk2(s[2 * 33], s[3 * 33]); o.z = pk2(s[4 * 33], s[5 * 33]); o.w = pk2(s[6 * 33], s[7 * 33]);
        *(u32x4*)(WT + (size_t)(drow0 + n) * K + k0 + 8 * c) = o; }
    LDS_WAIT(); asm volatile("" ::: "memory");
}
__device__ __forceinline__ void phase0(const Args& a, LAS unsigned char* lds, int G) {
    const int tid = threadIdx.x, lane = tid & 63, wave = __builtin_amdgcn_readfirstlane(tid >> 6);
    LAS float* scr = (LAS float*)(lds + wave * 16384);
    const int gw = blockIdx.x * NWAVES + wave, NGW = G * NWAVES;
    unsigned char* ws = a.ws;
    bf16* win_t = (bf16*)(ws + WS_WIN); bf16* wout_t = (bf16*)(ws + WS_WOUT); bf16* wup_t = (bf16*)(ws + WS_WUP); bf16* wdn_t = (bf16*)(ws + WS_WDN); bf16* poolw_t = (bf16*)(ws + WS_POOLW);
    constexpr int I_IN = 16 * 64, I_OUT = 16 * 32, I_UP = 16 * 176, I_DN = 44 * 32, I_PW = 32, I_ADA = 24 * ADA_KB;
    constexpr int NITEMS = I_ADA + I_IN + I_OUT + I_UP + I_DN + I_PW;
    for (int it = gw; it < NITEMS; it += NGW) {
        int r = it;
        if (r < I_ADA) {
            const int cb = r / ADA_KB, kb = r % ADA_KB, k0 = kb * 64, col = cb * 256 + lane * 4;
            for (int idx = lane; idx < 17 * 64; idx += 64) { const int rr = idx >> 6, kk = idx & 63; const float cv = rr < 16 ? a.c[rr * DM + k0 + kk] : a.c_ctx[k0 + kk]; scr[idx] = silu_acc(cv); }
            LDS_WAIT(); asm volatile("" ::: "memory");
            f32x4 acc[17];
#pragma unroll
            for (int rr = 0; rr < 17; ++rr) acc[rr] = (f32x4){0.f, 0.f, 0.f, 0.f};
            for (int kk = 0; kk < 64; ++kk) { const f32x4 w = *(const f32x4*)(a.w_ada + (size_t)(k0 + kk) * NMOD + col);
#pragma unroll
                for (int rr = 0; rr < 17; ++rr) acc[rr] += scr[rr * 64 + kk] * w; }
            if (kb == 0) { const f32x4 bv = *(const f32x4*)(a.b_ada + col);
#pragma unroll
                for (int rr = 0; rr < 17; ++rr) acc[rr] += bv; }
            float* mp = (float*)(ws + WS_MODP) + (size_t)kb * 17 * NMOD + col;
#pragma unroll
            for (int rr = 0; rr < 17; ++rr) *(f32x4*)(mp + (size_t)rr * NMOD) = acc[rr];
            LDS_WAIT(); asm volatile("" ::: "memory");
            continue; }
        r -= I_ADA;
        if (r < I_IN) { const int kb = r / 64, nb = r % 64; tr_item(a.w_in, INW, win_t, DM, kb * 64, nb * 32, nb * 32, scr, lane); continue; } r -= I_IN;
        if (r < I_OUT) { const int kb = r / 32, nb = r % 32; tr_item(a.w_out, DM, wout_t, DM, kb * 64, nb * 32, nb * 32, scr, lane); continue; } r -= I_OUT;
        if (r < I_UP) { const int kb = r / 176, nb = r % 176; const int c0 = nb * 32; int drow0;
            if (c0 < DFF) drow0 = 256 * (c0 / 128) + (c0 % 128); else { const int c1 = c0 - DFF; drow0 = 256 * (c1 / 128) + 128 + (c1 % 128); }
            tr_item(a.w_up, 2 * DFF, wup_t, DM, kb * 64, c0, drow0, scr, lane); continue; } r -= I_UP;
        if (r < I_DN) { const int kb = r / 32, nb = r % 32; tr_item(a.w_down, DM, wdn_t, DFF, kb * 64, nb * 32, nb * 32, scr, lane); continue; } r -= I_DN;
        { const int g = r / 8, q = r % 8, kb = q / 4, nb = q % 4; tr_item(a.pool_w + g * 16384, 128, poolw_t + g * 16384, 128, kb * 64, nb * 32, nb * 32, scr, lane); }
    }
    float* wg = (float*)(ws + WS_WG);
    for (int idx = blockIdx.x * NTHR + tid; idx < 16 * DM; idx += G * NTHR) { const int k = idx >> 4, j = idx & 15; wg[j * DM + k] = a.w_in[(size_t)k * INW + 2048 + j]; }
}

__device__ __forceinline__ float logsigmoid_f(float v) { return fminf(v, 0.f) - log1pf(__expf(-fabsf(v))); }
__device__ __forceinline__ float reduce16(float (&v)[16], int lane) {
    { const bool up = (lane & 32) != 0;
#pragma unroll
      for (int j = 0; j < 8; ++j) { const float send = up ? v[j] : v[j + 8]; const float keep = up ? v[j + 8] : v[j]; v[j] = keep + __shfl_xor(send, 32); } }
    { const bool up = (lane & 16) != 0;
#pragma unroll
      for (int j = 0; j < 4; ++j) { const float send = up ? v[j] : v[j + 4]; const float keep = up ? v[j + 4] : v[j]; v[j] = keep + __shfl_xor(send, 16); } }
    { const bool up = (lane & 8) != 0;
#pragma unroll
      for (int j = 0; j < 2; ++j) { const float send = up ? v[j] : v[j + 2]; const float keep = up ? v[j + 2] : v[j]; v[j] = keep + __shfl_xor(send, 8); } }
    { const bool up = (lane & 4) != 0; const float send = up ? v[0] : v[1]; const float keep = up ? v[1] : v[0]; v[0] = keep + __shfl_xor(send, 4); }
    float s = v[0]; s += __shfl_xor(s, 1); s += __shfl_xor(s, 2); return s;
}
__device__ __forceinline__ void p1_pair(const Args& a, const float* xr0, const float* xr1, int orow0, int orow1, const LAS float* S, const LAS float* H, const LAS float* WgL, int lane) {
    bf16* hx = (bf16*)(a.ws + WS_HX); float* gates = (float*)(a.ws + WS_GATES);
    float s0 = 0.f, s1 = 0.f;
#pragma unroll
    for (int j = 0; j < 4; ++j) { const f32x4 v0 = *(const f32x4*)(xr0 + 4 * lane + 256 * j), v1 = *(const f32x4*)(xr1 + 4 * lane + 256 * j);
        s0 += (v0.x * v0.x + v0.y * v0.y) + (v0.z * v0.z + v0.w * v0.w); s1 += (v1.x * v1.x + v1.y * v1.y) + (v1.z * v1.z + v1.w * v1.w); }
    const float r0 = rsqrtf(wave_sum(s0) * (1.f / DM) + EPS), r1 = rsqrtf(wave_sum(s1) * (1.f / DM) + EPS);
    float g0[16], g1[16];
#pragma unroll
    for (int g = 0; g < 16; ++g) { g0[g] = 0.f; g1[g] = 0.f; }
#pragma unroll 1
    for (int j = 0; j < 4; ++j) { const int k = 4 * lane + 256 * j;
        const f32x4 v0 = *(const f32x4*)(xr0 + k), v1 = *(const f32x4*)(xr1 + k);
        const f32x4 sv = *(const LAS f32x4*)(S + k), hv = *(const LAS f32x4*)(H + k);
        const f32x4 h0 = (v0 * r0) * sv + hv, h1 = (v1 * r1) * sv + hv;
        u32x2 w0, w1; w0.x = pk2(h0.x, h0.y); w0.y = pk2(h0.z, h0.w); w1.x = pk2(h1.x, h1.y); w1.y = pk2(h1.z, h1.w);
        *(u32x2*)(hx + (size_t)orow0 * DM + k) = w0; *(u32x2*)(hx + (size_t)orow1 * DM + k) = w1;
#pragma unroll
        for (int g = 0; g < 16; ++g) { const f32x4 wv = *(const LAS f32x4*)(WgL + g * DM + k);
            g0[g] += (h0.x * wv.x + h0.y * wv.y) + (h0.z * wv.z + h0.w * wv.w); g1[g] += (h1.x * wv.x + h1.y * wv.y) + (h1.z * wv.z + h1.w * wv.w); } }
    const float t0 = reduce16(g0, lane), t1 = reduce16(g1, lane);
    if ((lane & 3) == 0) { const int g = ((lane >> 5) & 1) * 8 + ((lane >> 4) & 1) * 4 + ((lane >> 3) & 1) * 2 + ((lane >> 2) & 1);
        const float bias = a.gate_bias[g]; float y0 = t0 + bias, y1 = t1 + bias;
        if (g >= 8) { y0 = logsigmoid_f(y0); y1 = logsigmoid_f(y1); }
        gates[(size_t)orow0 * 16 + g] = y0; gates[(size_t)orow1 * 16 + g] = y1; }
}
__device__ __forceinline__ void phase1(const Args& a, LAS unsigned char* lds, int G) {
    const int tid = threadIdx.x, lane = tid & 63, wave = __builtin_amdgcn_readfirstlane(tid >> 6);
    LAS float* S1 = (LAS float*)lds; LAS float* H1 = S1 + DM; LAS float* S1c = H1 + DM; LAS float* H1c = S1c + DM; LAS float* WgL = H1c + DM;
    const float* modp = (const float*)(a.ws + WS_MODP); float* mod = (float*)(a.ws + WS_MOD); const float* wg = (const float*)(a.ws + WS_WG);
    for (int rg = blockIdx.x; rg < 256; rg += G) {
        const int b = rg >> 4, sub = rg & 15;
        __syncthreads();
#pragma unroll 1
        for (int idx = tid; idx < DM; idx += NTHR) { float sh = 0.f, sc = 0.f, shc = 0.f, scc = 0.f;
#pragma unroll 4
            for (int kb = 0; kb < ADA_KB; ++kb) { const float* p = modp + (size_t)kb * 17 * NMOD; sh += p[b * NMOD + idx]; sc += p[b * NMOD + DM + idx]; shc += p[16 * NMOD + idx]; scc += p[16 * NMOD + DM + idx]; }
            const float n1 = a.norm1[idx]; S1[idx] = n1 * (1.f + sc); H1[idx] = sh; S1c[idx] = n1 * (1.f + scc); H1c[idx] = shc; }
        if (sub == 0)
#pragma unroll 1
          for (int idx = tid; idx < NMOD; idx += NTHR) { float s = 0.f;
#pragma unroll 4
            for (int kb = 0; kb < ADA_KB; ++kb) s += modp[(size_t)kb * 17 * NMOD + b * NMOD + idx]; mod[b * NMOD + idx] = s; }
#pragma unroll 2
        for (int idx = tid; idx < 16 * DM / 4; idx += NTHR) *(LAS f32x4*)(WgL + 4 * idx) = *(const f32x4*)(wg + 4 * idx);
        __syncthreads();
        const int lr0 = b * SEQ + sub * 128 + wave * 16;
#pragma unroll 1
        for (int i = 0; i < 16; i += 2) p1_pair(a, a.x + (size_t)(lr0 + i) * DM, a.x + (size_t)(lr0 + i + 1) * DM, lr0 + i, lr0 + i + 1, S1, H1, WgL, lane);
        const int cr0 = b * CTXL + sub * 16 + wave * 2;
        p1_pair(a, a.ctx + (size_t)cr0 * DM, a.ctx + (size_t)(cr0 + 1) * DM, ML + cr0, ML + cr0 + 1, S1c, H1c, WgL, lane);
    }
}

__device__ __forceinline__ void phase2b(const Args& a, int G) {
    const int tid = threadIdx.x, lane = tid & 63, wave = __builtin_amdgcn_readfirstlane(tid >> 6);
    const int gw = blockIdx.x * NWAVES + wave, NGW = G * NWAVES;
    const bf16* P = (const bf16*)(a.ws + WS_P); bf16* QK = (bf16*)(a.ws + WS_QK);
    const int c0 = lane * 8;
    float w0[8], w1[8], w2[8];
#pragma unroll
    for (int e = 0; e < 8; ++e) { w0[e] = a.conv_qk[c0 + e]; w1[e] = a.conv_qk[512 + c0 + e]; w2[e] = a.conv_qk[1024 + c0 + e]; }
    const float qs = (c0 < 256) ? 0.125f : 1.0f;
    for (int it = gw; it < MT / 16; it += NGW) {
        const int r0 = it * 16;
        const int t0 = (r0 < ML) ? (r0 % SEQ) : ((r0 - ML) % CTXL); const int tlen = (r0 < ML) ? SEQ : CTXL;
        u32x4 prev = (u32x4){0u, 0u, 0u, 0u}, cur, nxt;
        if (t0 != 0) prev = *(const u32x4*)(P + (size_t)(r0 - 1) * NP + 512 + c0);
        cur = *(const u32x4*)(P + (size_t)r0 * NP + 512 + c0);
        for (int i = 0; i < 16; ++i) {
            const bool has_next = (i < 15) || (t0 + 16 != tlen);
            nxt = (u32x4){0u, 0u, 0u, 0u};
            if (has_next) nxt = *(const u32x4*)(P + (size_t)(r0 + i + 1) * NP + 512 + c0);
            float y[8];
#pragma unroll
            for (int e = 0; e < 4; ++e) {
                y[2 * e] = w0[2 * e] * bflo(prev[e]) + w1[2 * e] * bflo(cur[e]) + w2[2 * e] * bflo(nxt[e]);
                y[2 * e + 1] = w0[2 * e + 1] * bfhi(prev[e]) + w1[2 * e + 1] * bfhi(cur[e]) + w2[2 * e + 1] * bfhi(nxt[e]); }
            u32x4 o;
#pragma unroll
            for (int e = 0; e < 4; ++e) o[e] = pk2(silu_acc(y[2 * e]) * qs, silu_acc(y[2 * e + 1]) * qs);
            *(u32x4*)(QK + (size_t)(r0 + i) * 512 + c0) = o;
            prev = cur; cur = nxt;
        }
    }
}

__device__ __forceinline__ void phase3_pool(const Args& a, LAS unsigned char* lds, int G) {
    const int tid = threadIdx.x;
    const bf16* P = (const bf16*)(a.ws + WS_P); bf16* MIX = (bf16*)(a.ws + WS_MIX);
    LAS float* dS = (LAS float*)lds;
    for (int it = blockIdx.x; it < (ML / 64) * 4; it += G) {
        const int tb = it >> 2, g = it & 3, tok0 = tb * 64, half = 1 << g;
        __syncthreads();
        for (int i = 0; i < 16; ++i) { const int idx = tid + NTHR * i, p = idx >> 7, c = idx & 127;
            int lo = p - half; if (lo < 0) lo = 0; int hi = p + half - 1; if (hi > 63) hi = 63;
            float s = 0.f; for (int q = lo; q <= hi; ++q) s += bf2f(P[(size_t)(tok0 + q) * NP + g * 128 + c]);
            dS[p * 128 + c] = s / (float)(hi - lo + 1) - bf2f(P[(size_t)(tok0 + p) * NP + g * 128 + c]); }
        __syncthreads();
        const int n = tid & 127, pq = tid >> 7;
        float acc[16];
#pragma unroll
        for (int i = 0; i < 16; ++i) acc[i] = 0.f;
        const float* W = a.pool_w + g * 16384 + n;
        for (int c = 0; c < 128; ++c) { const float w = W[c * 128];
#pragma unroll
            for (int i = 0; i < 16; ++i) acc[i] += dS[(pq + 4 * i) * 128 + c] * w; }
        const float ps = a.pool_scale[g * 128 + n];
#pragma unroll
        for (int i = 0; i < 16; ++i) { const unsigned w = pk2(acc[i] * ps, 0.f); MIX[(size_t)(tok0 + pq + 4 * i) * DM + g * 128 + n] = (bf16)(w & 0xffffu); }
    }
}

__device__ __forceinline__ void phase3_mlstm(const Args& a, LAS unsigned char* lds, int G) {
    const int tid = threadIdx.x;
    const bf16* P = (const bf16*)(a.ws + WS_P); const bf16* QK = (const bf16*)(a.ws + WS_QK); const float* gates = (const float*)(a.ws + WS_GATES);
    LAS float* qS = (LAS float*)lds; LAS float* kS = qS + 64 * 64; LAS float* vS = kS + 64 * 64; LAS float* igS = vS + 64 * 128; LAS float* lfS = igS + 64;
    const int v = tid >> 2, dq = tid & 3;
    for (int it = blockIdx.x; it < NB * NHEAD * 2; it += G) {
        const int dir = it & 1, hh = (it >> 1) & 3, b = it >> 3;
        float* H = (float*)(a.ws + (dir ? WS_HB : WS_HF));
        float C[16], nn[16]; float m = 0.f;
#pragma unroll
        for (int d = 0; d < 16; ++d) { C[d] = 0.f; nn[d] = 0.f; }
        for (int seg = 0; seg < 2; ++seg) {
            const int tlen = seg ? SEQ : CTXL; const int rbase = seg ? b * SEQ : ML + b * CTXL;
            for (int ch = 0; ch < tlen / 64; ++ch) {
                __syncthreads();
                for (int i = 0; i < 4; ++i) { const int idx = tid + NTHR * i, jj = idx >> 5, cix = idx & 31;
                    const int st = ch * 64 + jj, t = dir ? (tlen - 1 - st) : st; const size_t row = (size_t)(rbase + t);
                    const bf16* src; LAS float* dst;
                    if (cix < 8) { src = QK + row * 512 + hh * 64 + cix * 8; dst = qS + jj * 64 + cix * 8; }
                    else if (cix < 16) { src = QK + row * 512 + 256 + hh * 64 + (cix - 8) * 8; dst = kS + jj * 64 + (cix - 8) * 8; }
                    else { src = P + row * NP + 1024 + hh * 128 + (cix - 16) * 8; dst = vS + jj * 128 + (cix - 16) * 8; }
                    const u32x4 w = *(const u32x4*)src;
#pragma unroll
                    for (int e = 0; e < 4; ++e) { dst[2 * e] = bflo(w[e]); dst[2 * e + 1] = bfhi(w[e]); } }
                if (tid < 64) { const int st = ch * 64 + tid, t = dir ? (tlen - 1 - st) : st; const size_t row = (size_t)(rbase + t);
                    igS[tid] = gates[row * 16 + dir * 4 + hh]; lfS[tid] = gates[row * 16 + 8 + dir * 4 + hh]; }
                __syncthreads();
                for (int jj = 0; jj < 64; ++jj) {
                    const float ig = igS[jj], lf = lfS[jj];
                    const float mn = fmaxf(lf + m, ig), fd = __expf(lf + m - mn), iw = __expf(ig - mn); m = mn;
                    const float vv = vS[jj * 128 + v] * iw;
                    float num = 0.f, den = 0.f;
#pragma unroll
                    for (int d4 = 0; d4 < 4; ++d4) { const f32x4 kk = *(const LAS f32x4*)(kS + jj * 64 + dq * 16 + d4 * 4), qq = *(const LAS f32x4*)(qS + jj * 64 + dq * 16 + d4 * 4);
#pragma unroll
                        for (int e = 0; e < 4; ++e) { const int d = d4 * 4 + e; C[d] = fd * C[d] + vv * kk[e]; nn[d] = fd * nn[d] + iw * kk[e]; num += C[d] * qq[e]; den += nn[d] * qq[e]; } }
                    num += __shfl_xor(num, 1); num += __shfl_xor(num, 2); den += __shfl_xor(den, 1); den += __shfl_xor(den, 2);
                    if (seg && dq == 0) { const int st = ch * 64 + jj, t = dir ? (tlen - 1 - st) : st;
                        H[(size_t)(rbase + t) * 512 + hh * 128 + v] = num / fmaxf(fabsf(den), __expf(-m)); }
                }
            }
        }
    }
}


typedef short bf16x8 __attribute__((ext_vector_type(8)));
typedef short s16x4 __attribute__((ext_vector_type(4)));
typedef short v4i16_t __attribute__((ext_vector_type(4)));
typedef float f32x16 __attribute__((ext_vector_type(16)));
typedef __bf16 bf16x2v __attribute__((ext_vector_type(2)));
__device__ __forceinline__ f32x16 mfma32(bf16x8 a, bf16x8 b, f32x16 c) { return __builtin_amdgcn_mfma_f32_32x32x16_bf16(a, b, c, 0, 0, 0); }
__device__ __forceinline__ bf16x8 pack8(const f32x16& x, int ks) { u32x4 p; p.x = pk2(x[8 * ks], x[8 * ks + 1]); p.y = pk2(x[8 * ks + 2], x[8 * ks + 3]); p.z = pk2(x[8 * ks + 4], x[8 * ks + 5]); p.w = pk2(x[8 * ks + 6], x[8 * ks + 7]); return __builtin_bit_cast(bf16x8, p); }
__device__ __forceinline__ s16x4 tr_read(const LAS unsigned char* p) { return __builtin_bit_cast(s16x4, __builtin_amdgcn_ds_read_tr16_b64_v4i16((LAS v4i16_t*)p)); }
__device__ __forceinline__ bf16x8 cat8(s16x4 lo, s16x4 hi) { return __builtin_shufflevector(lo, hi, 0, 1, 2, 3, 4, 5, 6, 7); }
__device__ __forceinline__ bf16x8 ld_pi(const LAS unsigned char* tile, int row, int ch0, int hf) {
    const int f = (row ^ (row >> 3)) & 7;
    const u32x2 lo = *(const LAS u32x2*)(tile + row * 128 + ((ch0 ^ f) << 4) + 8 * hf), hi = *(const LAS u32x2*)(tile + row * 128 + (((ch0 + 1) ^ f) << 4) + 8 * hf);
    return __builtin_bit_cast(bf16x8, (u32x4){lo.x, lo.y, hi.x, hi.y});
}
__device__ __forceinline__ float dot2bf(unsigned a, unsigned b, float acc) { return __builtin_amdgcn_fdot2_f32_bf16(__builtin_bit_cast(bf16x2v, a), __builtin_bit_cast(bf16x2v, b), acc, false); }
__device__ __forceinline__ void glds16(const void* gsrc, unsigned lds_dst) { unsigned keep;
    asm volatile("s_mov_b32 %0, m0\n\ts_mov_b32 m0, %2\n\ts_nop 0\n\tglobal_load_lds_dwordx4 %1, off\n\ts_mov_b32 m0, %0" : "=&s"(keep) : "v"(gsrc), "s"(lds_dst) : "memory"); }
constexpr int ML_BUF = 20480, ML_VEC = 40960, ML_WAVE_LDS = 49152, ML_LDS0 = 32768, ML_NCH = CTXL / 64 + SEQ / 64;
__device__ __forceinline__ int ml_tokrow(int g, int pos, int dir, int b) {
    const int seg = g >= CTXL / 64, ch = seg ? g - CTXL / 64 : g, tlen = seg ? SEQ : CTXL, rbase = seg ? b * SEQ : ML + b * CTXL;
    const int st = ch * 64 + pos; return rbase + (dir ? (tlen - 1 - st) : st);
}
__device__ __forceinline__ void ml_issue(const bf16* P, const bf16* QK, unsigned dst, int g, int dir, int b, int hh, int vs, int lane) {
#pragma unroll
    for (int i = 0; i < 8; ++i) { const int rl = 8 * i + (lane >> 3), gch = (lane & 7) ^ ((rl ^ (rl >> 3)) & 7); const size_t row = (size_t)ml_tokrow(g, rl, dir, b);
        glds16(QK + row * 512 + hh * 64 + gch * 8, (unsigned)__builtin_amdgcn_readfirstlane(dst + i * 1024));
        glds16(QK + row * 512 + 256 + hh * 64 + gch * 8, (unsigned)__builtin_amdgcn_readfirstlane(dst + 8192 + i * 1024)); }
#pragma unroll
    for (int i = 0; i < 4; ++i) { const int rl = 16 * i + (lane >> 2); const size_t row = (size_t)ml_tokrow(g, rl, dir, b);
        glds16(P + row * NP + 1024 + hh * 128 + vs * 32 + (lane & 3) * 8, (unsigned)__builtin_amdgcn_readfirstlane(dst + 16384 + i * 1024)); }
}
__device__ __forceinline__ void mlstm_task(const Args& a, LAS unsigned char* wl, int tk, int lane) {
    const int vs = tk & 3, dir = (tk >> 2) & 1, hh = (tk >> 3) & 3, b = tk >> 5;
    const int c = lane & 31, hf = lane >> 5;
    const bf16* P = (const bf16*)(a.ws + WS_P); const bf16* QK = (const bf16*)(a.ws + WS_QK); const float* gates = (const float*)(a.ws + WS_GATES);
    float* H = (float*)(a.ws + (dir ? WS_HB : WS_HF));
    const unsigned wl_addr = (unsigned)(size_t)wl;
    LAS float* vec = (LAS float*)(wl + ML_VEC);
    const float L2E = 1.4426950408889634f;
    f32x16 ST0, ST1;
#pragma unroll
    for (int r = 0; r < 16; ++r) { ST0[r] = 0.f; ST1[r] = 0.f; }
    float nv0 = 0.f, nv1 = 0.f, m0 = 0.f;
    vec[320 + lane] = 0.f;
    const int q16 = (lane & 15) >> 2, p16 = lane & 3, blk = (lane >> 4) & 1;
    float ig_n = 0.f, lf_n = 0.f;
#pragma unroll 1
    for (int g = -1; g < ML_NCH; ++g) {
        const int buf = g & 1;
        asm volatile("s_waitcnt vmcnt(0) lgkmcnt(0)" ::: "memory");
        const float ig = ig_n, lf = lf_n;
        if (g + 1 < ML_NCH) {
            int lane_o = lane; asm volatile("" : "+v"(lane_o));
            ml_issue(P, QK, wl_addr + (buf ^ 1) * ML_BUF, g + 1, dir, b, hh, vs, lane_o);
            const size_t row = (size_t)ml_tokrow(g + 1, lane_o, dir, b); ig_n = gates[row * 16 + dir * 4 + hh]; lf_n = gates[row * 16 + 8 + dir * 4 + hh];
        }
        if (g < 0) continue;
        const bool want_h = g >= CTXL / 64;
        const LAS unsigned char* Qt = wl + buf * ML_BUF; const LAS unsigned char* Kt = Qt + 8192; const LAS unsigned char* Vt = Qt + 16384;
        float bsum = lf;
#pragma unroll
        for (int off = 1; off < 64; off <<= 1) { const float t = __shfl_up(bsum, off); if (lane >= off) bsum += t; }
        const float av = ig - bsum;
        float cm = av;
#pragma unroll
        for (int off = 1; off < 64; off <<= 1) { const float t = __shfl_up(cm, off); if (lane >= off) cm = fmaxf(cm, t); }
        const float M = fmaxf(m0, cm);
        const float bl = __shfl(bsum, 63), M63 = __shfl(M, 63);
        const float a2 = av * L2E, M2 = M * L2E, m02 = m0 * L2E, M632 = M63 * L2E;
        const float decay = __builtin_amdgcn_exp2f(m02 - M632);
        vec[256 + lane] = __builtin_amdgcn_exp2f(a2 - M632);
        if (want_h) { vec[lane] = a2; vec[64 + lane] = M2; vec[128 + lane] = __builtin_amdgcn_exp2f(m02 - M2); vec[192 + lane] = __builtin_amdgcn_exp2f(-(bsum * L2E + M2)); }
        if (want_h) {
            bf16x8 Qf[2][2][2];
#pragma unroll
            for (int jt = 0; jt < 2; ++jt)
#pragma unroll
                for (int dt = 0; dt < 2; ++dt)
#pragma unroll
                    for (int ks = 0; ks < 2; ++ks) Qf[jt][dt][ks] = ld_pi(Qt, 32 * jt + c, 4 * dt + 2 * ks, hf);
            f32x16 S00, S01, S11;
            int c_k = c; asm volatile("" : "+v"(c_k));
#pragma unroll
            for (int r = 0; r < 16; ++r) { S00[r] = 0.f; S01[r] = 0.f; S11[r] = 0.f; }
#pragma unroll
            for (int dt = 0; dt < 2; ++dt)
#pragma unroll
                for (int ks = 0; ks < 2; ++ks) { const bf16x8 k0 = ld_pi(Kt, c_k, 4 * dt + 2 * ks, hf), k1 = ld_pi(Kt, 32 + c_k, 4 * dt + 2 * ks, hf);
                    S00 = mfma32(k0, Qf[0][dt][ks], S00); S01 = mfma32(k0, Qf[1][dt][ks], S01); S11 = mfma32(k1, Qf[1][dt][ks], S11); }
            __builtin_amdgcn_sched_barrier(0);
            f32x16 Y0, Y1;
#pragma unroll
            for (int r = 0; r < 16; ++r) { Y0[r] = 0.f; Y1[r] = 0.f; }
#pragma unroll
            for (int ks = 0; ks < 2; ++ks) { const bf16x8 s0 = pack8(ST0, ks), s1 = pack8(ST1, ks);
                Y0 = mfma32(s0, Qf[0][0][ks], Y0); Y1 = mfma32(s0, Qf[1][0][ks], Y1); Y0 = mfma32(s1, Qf[0][1][ks], Y0); Y1 = mfma32(s1, Qf[1][1][ks], Y1); }
            __builtin_amdgcn_sched_barrier(0);
            float qn0 = 0.f, qn1 = 0.f;
#pragma unroll
            for (int dt = 0; dt < 2; ++dt)
#pragma unroll
                for (int ks = 0; ks < 2; ++ks) { const u32x4 x0 = __builtin_bit_cast(u32x4, Qf[0][dt][ks]), x1 = __builtin_bit_cast(u32x4, Qf[1][dt][ks]);
                    const f32x4 lo = *(const LAS f32x4*)(vec + 320 + 32 * dt + 16 * ks + 4 * hf), hi = *(const LAS f32x4*)(vec + 320 + 32 * dt + 16 * ks + 8 + 4 * hf);
                    const u32x4 np = (u32x4){pk2(lo.x, lo.y), pk2(lo.z, lo.w), pk2(hi.x, hi.y), pk2(hi.z, hi.w)};
#pragma unroll
                    for (int w = 0; w < 4; ++w) { qn0 = dot2bf(x0[w], np[w], qn0); qn1 = dot2bf(x1[w], np[w], qn1); } }
            qn0 += __shfl_xor(qn0, 32); qn1 += __shfl_xor(qn1, 32);
            __builtin_amdgcn_sched_barrier(0);
            const float M2j0 = vec[64 + c], M2j1 = vec[96 + c], w0 = vec[128 + c], w1 = vec[160 + c], thr0 = vec[192 + c], thr1 = vec[224 + c];
            float den0 = 0.f, den1 = 0.f;
#pragma unroll
            for (int q4 = 0; q4 < 4; ++q4) { const f32x4 a0 = *(const LAS f32x4*)(vec + 8 * q4 + 4 * hf), a1 = *(const LAS f32x4*)(vec + 32 + 8 * q4 + 4 * hf);
#pragma unroll
                for (int e = 0; e < 4; ++e) { const int r = 4 * q4 + e; const int sl = e + 8 * q4 + 4 * hf;
                    float x00 = S00[r] * __builtin_amdgcn_exp2f(a0[e] - M2j0); x00 = (sl <= c) ? x00 : 0.f; den0 += x00; S00[r] = x00;
                    const float x01 = S01[r] * __builtin_amdgcn_exp2f(a0[e] - M2j1); den1 += x01; S01[r] = x01;
                    float x11 = S11[r] * __builtin_amdgcn_exp2f(a1[e] - M2j1); x11 = (sl <= c) ? x11 : 0.f; den1 += x11; S11[r] = x11; } }
            __builtin_amdgcn_sched_barrier(0);
            den0 += __shfl_xor(den0, 32); den1 += __shfl_xor(den1, 32);
            den0 += w0 * qn0; den1 += w1 * qn1;
            const float rinv0 = 1.0f / fmaxf(fabsf(den0), thr0), rinv1 = 1.0f / fmaxf(fabsf(den1), thr1);
#pragma unroll
            for (int r = 0; r < 16; ++r) { Y0[r] *= w0; Y1[r] *= w1; }
            bf16x8 Vf[2][2];
#pragma unroll
            for (int st = 0; st < 2; ++st)
#pragma unroll
                for (int ks = 0; ks < 2; ++ks) { const int row = 32 * st + 16 * ks + 4 * hf + q16; const LAS unsigned char* pp = Vt + row * 64 + blk * 32 + p16 * 8;
                    Vf[st][ks] = cat8(tr_read(pp), tr_read(pp + 8 * 64)); }
#pragma unroll
            for (int ks = 0; ks < 2; ++ks) { Y0 = mfma32(Vf[0][ks], pack8(S00, ks), Y0); Y1 = mfma32(Vf[0][ks], pack8(S01, ks), Y1); Y1 = mfma32(Vf[1][ks], pack8(S11, ks), Y1); }
            __builtin_amdgcn_sched_barrier(0);
            float* h0 = H + (size_t)ml_tokrow(g, c, dir, b) * 512 + hh * 128 + vs * 32 + 4 * hf;
            float* h1 = H + (size_t)ml_tokrow(g, 32 + c, dir, b) * 512 + hh * 128 + vs * 32 + 4 * hf;
#pragma unroll
            for (int q4 = 0; q4 < 4; ++q4) { *(f32x4*)(h0 + 8 * q4) = (f32x4){Y0[4 * q4] * rinv0, Y0[4 * q4 + 1] * rinv0, Y0[4 * q4 + 2] * rinv0, Y0[4 * q4 + 3] * rinv0};
                *(f32x4*)(h1 + 8 * q4) = (f32x4){Y1[4 * q4] * rinv1, Y1[4 * q4 + 1] * rinv1, Y1[4 * q4 + 2] * rinv1, Y1[4 * q4 + 3] * rinv1}; }
        }
        __builtin_amdgcn_sched_barrier(0);
        float np0 = 0.f, np1 = 0.f;
#pragma unroll
        for (int r = 0; r < 16; ++r) { ST0[r] *= decay; ST1[r] *= decay; }
#pragma unroll
        for (int st = 0; st < 2; ++st)
#pragma unroll
            for (int ks = 0; ks < 2; ++ks) {
                const f32x4 wlo = *(const LAS f32x4*)(vec + 256 + 32 * st + 16 * ks + 4 * hf), whi = *(const LAS f32x4*)(vec + 256 + 32 * st + 16 * ks + 8 + 4 * hf);
                const int vrow = 32 * st + 16 * ks + 4 * hf + q16; const LAS unsigned char* vpp = Vt + vrow * 64 + blk * 32 + p16 * 8;
                const u32x4 vw = __builtin_bit_cast(u32x4, cat8(tr_read(vpp), tr_read(vpp + 8 * 64)));
                u32x4 sw; sw.x = pk2(bflo(vw.x) * wlo.x, bfhi(vw.x) * wlo.y); sw.y = pk2(bflo(vw.y) * wlo.z, bfhi(vw.y) * wlo.w); sw.z = pk2(bflo(vw.z) * whi.x, bfhi(vw.z) * whi.y); sw.w = pk2(bflo(vw.w) * whi.z, bfhi(vw.w) * whi.w);
                const bf16x8 Vw = __builtin_bit_cast(bf16x8, sw);
                const u32x4 wkp = (u32x4){pk2(wlo.x, wlo.y), pk2(wlo.z, wlo.w), pk2(whi.x, whi.y), pk2(whi.z, whi.w)};
                int q16o = q16; asm volatile("" : "+v"(q16o));
                const int row = 32 * st + 16 * ks + 4 * hf + q16o; const int f0 = (row ^ (row >> 3)) & 7, f1 = ((row + 8) ^ ((row + 8) >> 3)) & 7;
#pragma unroll
                for (int dt = 0; dt < 2; ++dt) { const int ch = 4 * dt + 2 * blk + (p16 >> 1);
                    const bf16x8 kt = cat8(tr_read(Kt + row * 128 + ((ch ^ f0) << 4) + (p16 & 1) * 8), tr_read(Kt + (row + 8) * 128 + ((ch ^ f1) << 4) + (p16 & 1) * 8));
                    const u32x4 kw = __builtin_bit_cast(u32x4, kt);
                    if (dt == 0) { ST0 = mfma32(kt, Vw, ST0);
#pragma unroll
                        for (int w = 0; w < 4; ++w) np0 = dot2bf(kw[w], wkp[w], np0); }
                    else { ST1 = mfma32(kt, Vw, ST1);
#pragma unroll
                        for (int w = 0; w < 4; ++w) np1 = dot2bf(kw[w], wkp[w], np1); } }
                __builtin_amdgcn_sched_barrier(0);
            }
        np0 += __shfl_xor(np0, 32); np1 += __shfl_xor(np1, 32);
        nv0 = decay * nv0 + np0; nv1 = decay * nv1 + np1;
        vec[320 + lane] = hf ? nv1 : nv0;
        m0 = bl + M63;
    }
}
__device__ __forceinline__ void phase3_mlstm_fast(const Args& a, LAS unsigned char* lds, int G) {
    const int tid = threadIdx.x, lane = tid & 63, wave = __builtin_amdgcn_readfirstlane(tid >> 6);
    if (wave < 2) { for (int tk = blockIdx.x * 2 + wave; tk < NB * NHEAD * 2 * 4; tk += 2 * G) mlstm_task(a, lds + ML_LDS0 + wave * ML_WAVE_LDS, tk, lane); }
}

__device__ __forceinline__ void phase4(const Args& a, int G) {
    const int tid = threadIdx.x, lane = tid & 63, wave = __builtin_amdgcn_readfirstlane(tid >> 6);
    const int gw = blockIdx.x * NWAVES + wave, NGW = G * NWAVES;
    const bf16* P = (const bf16*)(a.ws + WS_P); bf16* MIX = (bf16*)(a.ws + WS_MIX); const float* HF = (const float*)(a.ws + WS_HF); const float* HB = (const float*)(a.ws + WS_HB);
    const int c0 = lane * 8;
    float hn[8];
#pragma unroll
    for (int e = 0; e < 8; ++e) hn[e] = a.head_norm[c0 + e];
    for (int row = gw; row < ML; row += NGW) {
        const f32x4 f0 = *(const f32x4*)(HF + (size_t)row * 512 + c0), f1 = *(const f32x4*)(HF + (size_t)row * 512 + c0 + 4);
        const f32x4 b0 = *(const f32x4*)(HB + (size_t)row * 512 + c0), b1 = *(const f32x4*)(HB + (size_t)row * 512 + c0 + 4);
        const u32x4 ow = *(const u32x4*)(P + (size_t)row * NP + 1536 + c0);
        float h[8];
#pragma unroll
        for (int e = 0; e < 4; ++e) { h[e] = f0[e] + b0[e]; h[4 + e] = f1[e] + b1[e]; }
        float ss = 0.f;
#pragma unroll
        for (int e = 0; e < 8; ++e) ss += h[e] * h[e];
        ss += __shfl_xor(ss, 1); ss += __shfl_xor(ss, 2); ss += __shfl_xor(ss, 4); ss += __shfl_xor(ss, 8);
        const float r = rsqrtf(ss * (1.f / DV) + EPS);
        float o[8];
#pragma unroll
        for (int e = 0; e < 4; ++e) { o[2 * e] = bflo(ow[e]); o[2 * e + 1] = bfhi(ow[e]); }
        u32x4 w;
#pragma unroll
        for (int e = 0; e < 4; ++e) { const float y0 = h[2 * e] * r * hn[2 * e] / (1.f + __expf(-o[2 * e])), y1 = h[2 * e + 1] * r * hn[2 * e + 1] / (1.f + __expf(-o[2 * e + 1])); w[e] = pk2(y0, y1); }
        *(u32x4*)(MIX + (size_t)row * DM + 512 + c0) = w;
    }
}

template <bool FINAL> __device__ __forceinline__ void phase_rownorm(const Args& a, int G) {
    const int tid = threadIdx.x, lane = tid & 63, wave = __builtin_amdgcn_readfirstlane(tid >> 6);
    const int gw = blockIdx.x * NWAVES + wave, NGW = G * NWAVES;
    const float* mod = (const float*)(a.ws + WS_MOD); bf16* h2 = (bf16*)(a.ws + WS_HX);
    for (int row = gw; row < ML; row += NGW) {
        float* xr = a.out + (size_t)row * DM;
        f32x4 v[4]; float s = 0.f;
#pragma unroll
        for (int j = 0; j < 4; ++j) { v[j] = *(const f32x4*)(xr + 4 * lane + 256 * j); s += (v[j].x * v[j].x + v[j].y * v[j].y) + (v[j].z * v[j].z + v[j].w * v[j].w); }
        const float r = rsqrtf(wave_sum(s) * (1.f / DM) + EPS);
        if (FINAL) {
#pragma unroll
            for (int j = 0; j < 4; ++j) { const f32x4 nf = *(const f32x4*)(a.norm_f + 4 * lane + 256 * j); *(f32x4*)(xr + 4 * lane + 256 * j) = (v[j] * r) * nf; }
        } else {
            const int b = row / SEQ; const float* mp = mod + (size_t)b * NMOD;
#pragma unroll
            for (int j = 0; j < 4; ++j) { const int k = 4 * lane + 256 * j; const f32x4 n2 = *(const f32x4*)(a.norm2 + k), sh = *(const f32x4*)(mp + 3 * DM + k), sc = *(const f32x4*)(mp + 4 * DM + k);
                const f32x4 h = ((v[j] * r) * n2) * (sc + 1.0f) + sh; u32x2 w; w.x = pk2(h.x, h.y); w.y = pk2(h.z, h.w); *(u32x2*)(h2 + (size_t)row * DM + k) = w; }
        }
    }
}


typedef GAS unsigned gu32;
#define RLX_AGENT __ATOMIC_RELAXED, __HIP_MEMORY_SCOPE_AGENT
constexpr int MISC_OFF = RING_BYTES + 320;
constexpr size_t CTL_ZERO_BYTES = 16384;
#define XB_TMO      128
#define XB_XCNT(j)  (256  + 64 * (j))
#define XB_XSUB(j)  (1280 + 64 * (j))
#define XB_XGEN(j)  (2304 + 64 * (j))
#define XB_TOP      3328
#define XB_TOPGEN   3392
#define XCD_BAR_WORDS 3456
#define XB_SPIN_CAP (1u << 18)

__device__ __forceinline__ unsigned xb_ld(unsigned* p)              { return __hip_atomic_load(p, __ATOMIC_RELAXED, __HIP_MEMORY_SCOPE_AGENT); }
__device__ __forceinline__ unsigned xb_add(unsigned* p, unsigned v) { return __hip_atomic_fetch_add(p, v, __ATOMIC_RELAXED, __HIP_MEMORY_SCOPE_AGENT); }
__device__ __forceinline__ unsigned xb_xcc_id() { return (unsigned)__builtin_amdgcn_s_getreg((3 << 11) | 20) & 0xFu; }
#define XB_SPIN(cond, bar) do { unsigned _sp = 0; while (cond) { __builtin_amdgcn_s_sleep(1); \
    if ((++_sp & 255u) == 0u) { if (xb_ld(&(bar)[XB_TMO])) break; if (_sp > XB_SPIN_CAP) { atomicAdd(&(bar)[XB_TMO], 1u); break; } } } } while (0)

struct XcdBarrier {
    unsigned* bar; unsigned x;
    volatile LAS unsigned* st;
};

__device__ __forceinline__ XcdBarrier xcd_barrier_post(unsigned* bar, volatile LAS unsigned* st) {
    XcdBarrier b; b.bar = bar; b.x = xb_xcc_id(); b.st = st;
    if (threadIdx.x == 0) (void)xb_add(&bar[XB_XCNT(b.x)], 1u);
    return b;
}
__device__ __forceinline__ void xcd_barrier_complete(unsigned* bar, unsigned x, unsigned& nloc, unsigned& nx) {
    const unsigned G = gridDim.x * gridDim.y * gridDim.z;
    unsigned sum, cnt, mine, sp = 0u;
    for (;;) {
        sum = 0u; cnt = 0u; mine = 0u;
#pragma unroll
        for (unsigned j = 0; j < 16; ++j) { const unsigned c = xb_ld(&bar[XB_XCNT(j)]); sum += c; cnt += (c > 0u) ? 1u : 0u; mine = (j == x) ? c : mine; }
        if (sum == G) break;
        __builtin_amdgcn_s_sleep(1);
        if ((++sp & 255u) == 0u) { if (xb_ld(&bar[XB_TMO])) break; if (sp > XB_SPIN_CAP) { atomicAdd(&bar[XB_TMO], 1u); break; } }
    }
    nloc = mine > 0u ? mine : 1u; nx = cnt > 0u ? cnt : 1u;
}

__device__ __forceinline__ void xcd_barrier(const XcdBarrier& b) {
    asm volatile("s_waitcnt vmcnt(0)" ::: "memory");
    __syncthreads();
    if (threadIdx.x == 0) {
        unsigned* bar = b.bar;
        __builtin_amdgcn_s_waitcnt(0);
        unsigned nloc = b.st[0], nx = b.st[1];
        if (nloc == 0u) { xcd_barrier_complete(bar, b.x, nloc, nx); b.st[0] = nloc; b.st[1] = nx; }
        const unsigned old = xb_add(&bar[XB_XSUB(b.x)], 1u);
        const unsigned gen = old / nloc;
        if (old + 1u == (gen + 1u) * nloc) {
            __builtin_amdgcn_fence(__ATOMIC_RELEASE, "agent");
            asm volatile("s_waitcnt vmcnt(0)" ::: "memory");
            const unsigned og = xb_add(&bar[XB_TOP], 1u);
            const unsigned tg = og / nx;
            if (og + 1u == (tg + 1u) * nx) xb_add(&bar[XB_TOPGEN], 1u);
            else XB_SPIN(xb_ld(&bar[XB_TOPGEN]) == tg, bar);
            __builtin_amdgcn_fence(__ATOMIC_ACQUIRE, "agent");
            xb_add(&bar[XB_XGEN(b.x)], 1u);
            asm volatile("s_waitcnt vmcnt(0)" ::: "memory");
        } else {
            XB_SPIN(xb_ld(&bar[XB_XGEN(b.x)]) == gen, bar);
            __builtin_amdgcn_fence(__ATOMIC_ACQUIRE, "agent");
            asm volatile("s_waitcnt vmcnt(0)" ::: "memory");
        }
    }
    __syncthreads();
}

constexpr int N_PHASES = 11;
__global__ void __launch_bounds__(NTHR, 2) fwd_kernel(Args a) {
    extern __shared__ __attribute__((aligned(16))) unsigned char lds_raw[];
    LAS unsigned char* lds = (LAS unsigned char*)lds_raw;
    const int G = gridDim.x;
    const int lo = a.ph_lo, hi = a.ph_hi;
    for (int u = threadIdx.x; u < (LDS_BYTES - RING_BYTES) / 4; u += NTHR) ((LAS unsigned*)(lds + RING_BYTES))[u] = 0u;
    __syncthreads();
    XcdBarrier bar = xcd_barrier_post((unsigned*)(a.ws + WS_CTL), (volatile LAS unsigned*)(lds + MISC_OFF) + 8);
#ifndef PHASE_MASK
#define PHASE_MASK 0x7ff
#endif
#define IN(k) ((((PHASE_MASK) >> (k)) & 1) && lo <= (k) && (k) < hi)
#define SEAM(k) do { if (IN(k) && IN((k) + 1)) xcd_barrier(bar); } while (0)
    unsigned char* ws = a.ws;
    if (IN(0)) { phase0(a, lds, G); } SEAM(0);
    if (IN(1)) { phase1(a, lds, G); } SEAM(1);
    if (IN(2)) {
        pg8::Gemm g{(const bf16*)(ws + WS_HX), (const bf16*)(ws + WS_WIN), MT, NP, DM}; pg8::StaticOrder S; S.init(MT, NP, G, (int)blockIdx.x);
        pg8::EpiBf16Plain E{(bf16*)(ws + WS_P), NP};
        pg8::gemm_phase<pg8::EpiBf16Plain, pg8::StaticOrder, true, true>(lds, g, S, E);
    } SEAM(2);
    if (IN(3)) { phase2b(a, G); } SEAM(3);
    if (IN(4)) { phase3_pool(a, lds, G); phase3_mlstm_fast(a, lds, G); } SEAM(4);
    if (IN(5)) { phase4(a, G); } SEAM(5);
    if (IN(6)) {
        pg8::Gemm g{(const bf16*)(ws + WS_MIX), (const bf16*)(ws + WS_WOUT), ML, DM, DM}; pg8::StaticOrder S; S.init(ML, DM, G, (int)blockIdx.x);
        pg8::EpiResGate E{a.x, a.out, DM, (const float*)(ws + WS_MOD) + 2 * DM, NMOD, SEQ / 256};
        pg8::gemm_phase<pg8::EpiResGate, pg8::StaticOrder, true, true>(lds, g, S, E);
    } SEAM(6);
    if (IN(7)) { phase_rownorm<false>(a, G); } SEAM(7);
    if (IN(8)) {
        pg8::Gemm g{(const bf16*)(ws + WS_HX), (const bf16*)(ws + WS_WUP), ML, 2 * DFF, DM}; pg8::StaticOrder S; S.init(ML, 2 * DFF, G, (int)blockIdx.x);
        pg8::EpiSwiglu E{(bf16*)(ws + WS_HID), DFF};
        pg8::gemm_phase<pg8::EpiSwiglu, pg8::StaticOrder, true, true>(lds, g, S, E);
    } SEAM(8);
    if (IN(9)) {
        pg8::Gemm g{(const bf16*)(ws + WS_HID), (const bf16*)(ws + WS_WDN), ML, DM, DFF}; pg8::StaticOrder S; S.init(ML, DM, G, (int)blockIdx.x);
        pg8::EpiResGate E{a.out, a.out, DM, (const float*)(ws + WS_MOD) + 5 * DM, NMOD, SEQ / 256};
        pg8::gemm_phase<pg8::EpiResGate, pg8::StaticOrder, true, true>(lds, g, S, E);
    } SEAM(9);
    if (IN(10)) { phase_rownorm<true>(a, G); }
#undef IN
#undef SEAM
}

#ifndef N_LAUNCHES
#define N_LAUNCHES 1
#endif
extern "C" void kernel_launch(void* const* d_in, const int* in_sizes, int n_in, void* d_out, int out_size, void* d_ws, size_t ws_size, hipStream_t stream) {
    static int grid = 0;
    if (grid == 0) {
        if (n_in != 18 || out_size != ML * DM || ws_size < WS_END) { fprintf(stderr, "kernel_launch: unexpected shapes (n_in %d out %d ws %zu)\n", n_in, out_size, ws_size); grid = -1; return; }
        int dev = 0, cus = 0, per_cu = 0;
        hipGetDevice(&dev); hipDeviceGetAttribute(&cus, hipDeviceAttributeMultiprocessorCount, dev);
        if (hipFuncSetAttribute((const void*)fwd_kernel, hipFuncAttributeMaxDynamicSharedMemorySize, LDS_BYTES) != hipSuccess) { fprintf(stderr, "kernel_launch: hipFuncSetAttribute failed\n"); grid = -1; return; }
        if (hipOccupancyMaxActiveBlocksPerMultiprocessor(&per_cu, (const void*)fwd_kernel, NTHR, LDS_BYTES) != hipSuccess || per_cu < 1) { fprintf(stderr, "kernel_launch: occupancy query says %d\n", per_cu); per_cu = 1; }
        (void)hipGetLastError();
        grid = cus * (per_cu > 1 ? 1 : per_cu);
        if (grid <= 0) grid = 256;
    }
    if (grid < 0) return;
    Args a{};
    a.x = (const float*)d_in[0]; a.c = (const float*)d_in[1]; a.ctx = (const float*)d_in[2]; a.c_ctx = (const float*)d_in[3]; a.w_ada = (const float*)d_in[4]; a.b_ada = (const float*)d_in[5];
    a.norm1 = (const float*)d_in[6]; a.w_in = (const float*)d_in[7]; a.conv_qk = (const float*)d_in[8]; a.gate_bias = (const float*)d_in[9]; a.pool_w = (const float*)d_in[10]; a.pool_scale = (const float*)d_in[11];
    a.head_norm = (const float*)d_in[12]; a.w_out = (const float*)d_in[13]; a.norm2 = (const float*)d_in[14]; a.w_up = (const float*)d_in[15]; a.w_down = (const float*)d_in[16]; a.norm_f = (const float*)d_in[17];
    a.out = (float*)d_out; a.ws = (unsigned char*)d_ws;
    if (hipMemsetAsync((char*)d_ws + WS_CTL, 0, CTL_ZERO_BYTES, stream) != hipSuccess) { fprintf(stderr, "kernel_launch: memset failed\n"); return; }
#if N_LAUNCHES == 1
    a.ph_lo = 0; a.ph_hi = N_PHASES;
    void* args[] = {&a};
    hipError_t e = hipLaunchCooperativeKernel((const void*)fwd_kernel, dim3(grid), dim3(NTHR), args, LDS_BYTES, stream);
    if (e != hipSuccess) fprintf(stderr, "cooperative launch failed: %s (grid %d)\n", hipGetErrorString(e), grid);
#else
    for (int p = 0; p < N_PHASES; ++p) { a.ph_lo = p; a.ph_hi = p + 1; hipLaunchKernelGGL(fwd_kernel, dim3(grid), dim3(NTHR), LDS_BYTES, stream, a); }
#endif
}
```

```cpp
#include <hip/hip_runtime.h>
#include <hip/hip_cooperative_groups.h>
#include <cstdio>
#include <cstdint>
namespace cg = cooperative_groups;
namespace pg8 {
#define PG8_LAS __attribute__((address_space(3)))
typedef unsigned short bf16_t;
typedef short bf16x8 __attribute__((ext_vector_type(8)));
typedef float f32x4 __attribute__((ext_vector_type(4)));
typedef unsigned u32x4 __attribute__((ext_vector_type(4)));
constexpr int BM = 256, BK = 64, HALF = 128, HTB = HALF * BK * 2  , STAGE_BYTES = 8 * HTB, NXCD = 8, WGM = 8;

__host__ __device__ __forceinline__ int lds_byte(int r, int c) { const int st = (r >> 4) * 2 + (c >> 5), rr = r & 15, cc = c & 31, ob = rr * 64 + cc * 2; return st * 1024 + (ob ^ (((ob >> 9) & 1) << 5)); }
__host__ __device__ __forceinline__ void stage_rc(int b, int& R, int& C) { const int st = b / 1024, sb = b % 1024, swz = sb ^ (((sb >> 9) & 1) << 5); R = (st >> 1) * 16 + swz / 64; C = (st & 1) * 32 + (swz % 64) / 2; }
__host__ __device__ __forceinline__ int perm32(int rho) { const int n = rho >> 4, i = rho & 15; return 8 * (i >> 2) + 4 * n + (i & 3); }

struct Unit { int pm, pn; };
struct Gemm { const bf16_t* A; const bf16_t* Bt; int M, N, K; };

struct StaticOrder {
    int nM, nN, nwg, G, c;
    __host__ __device__ void init(int M, int N, int G_, int c_) { nM = M / BM; nN = N / BM; nwg = nM * nN; G = G_; c = c_; }
    __host__ __device__ bool next(int i, Unit& u) const {
        const long L = (long)i * G + c; if (L >= nwg) return false;
        int wgid = (int)L; { const int q = nwg / NXCD, r = nwg % NXCD, xcd = wgid % NXCD, off = wgid / NXCD; wgid = (xcd < r ? xcd * (q + 1) : r * (q + 1) + (xcd - r) * q) + off; }
        const int nig = WGM * nN, gid = wgid / nig, fm = gid * WGM, gsz = (nM - fm) < WGM ? (nM - fm) : WGM;
        u.pm = fm + ((wgid % nig) % gsz); u.pn = (wgid % nig) / gsz; return true;
    }
    __device__ __forceinline__ void a_ready(const Unit&) const {}
    __device__ __forceinline__ void done(const Unit&) const {}
};


typedef float f32x2 __attribute__((ext_vector_type(2)));
typedef __bf16 bf16x2_t __attribute__((ext_vector_type(2)));
__device__ __forceinline__ unsigned cvt_pk_bf16(float lo, float hi) { f32x2 v = {lo, hi}; bf16x2_t b = __builtin_convertvector(v, bf16x2_t); return __builtin_bit_cast(unsigned, b); }

struct EpiBf16Plain {
    static constexpr bool PERM = true, AFTER_DRAIN = false;
    bf16_t* O; int ldc;
    __device__ __forceinline__ void operator()(const f32x4 (&acc)[2][2][4][2], const Unit& u, int wr, int wc, int fr, int fq) const {
        const int row0 = u.pm * BM + wr * 64 + fr; const int col0 = u.pn * BM + wc * 32 + 8 * fq;
#pragma unroll
        for (int ai = 0; ai < 2; ++ai)
#pragma unroll
            for (int m = 0; m < 4; ++m) { bf16_t* rowp = O + (size_t)(row0 + ai * HALF + m * 16) * ldc + col0;
#pragma unroll
                for (int bj = 0; bj < 2; ++bj) { const f32x4 v0 = acc[ai][bj][m][0], v1 = acc[ai][bj][m][1];
                    u32x4 w; w.x = cvt_pk_bf16(v0[0], v0[1]); w.y = cvt_pk_bf16(v0[2], v0[3]); w.z = cvt_pk_bf16(v1[0], v1[1]); w.w = cvt_pk_bf16(v1[2], v1[3]);
                    *(u32x4*)(rowp + bj * HALF) = w; } }
    }
};
struct EpiResGate {
    static constexpr bool PERM = false, AFTER_DRAIN = false;
    const float* base; float* out; int ldc; const float* gate; int gate_stride; int tiles_per_batch;
    __device__ __forceinline__ void operator()(const f32x4 (&acc)[2][2][4][2], const Unit& u, int wr, int wc, int fr, int fq) const {
        const int row0 = u.pm * BM + wr * 64 + fr, col0 = u.pn * BM + wc * 32 + 4 * fq;
        const float* gp = gate + (size_t)(u.pm / tiles_per_batch) * gate_stride + col0;
        f32x4 gv[2][2];
#pragma unroll
        for (int bj = 0; bj < 2; ++bj)
#pragma unroll
            for (int n = 0; n < 2; ++n) gv[bj][n] = *(const f32x4*)(gp + bj * HALF + n * 16);
#pragma unroll
        for (int ai = 0; ai < 2; ++ai)
#pragma unroll
            for (int m = 0; m < 4; ++m) { const size_t off = (size_t)(row0 + ai * HALF + m * 16) * ldc + col0;
#pragma unroll
                for (int bj = 0; bj < 2; ++bj)
#pragma unroll
                    for (int n = 0; n < 2; ++n) { const f32x4 bs = *(const f32x4*)(base + off + bj * HALF + n * 16);
                        *(f32x4*)(out + off + bj * HALF + n * 16) = bs + gv[bj][n] * acc[ai][bj][m][n]; } }
    }
};
__device__ __forceinline__ float silu_f(float g) { return g * __builtin_amdgcn_rcpf(1.0f + __builtin_amdgcn_exp2f(-1.4426950408889634f * g)); }
struct EpiSwiglu {
    static constexpr bool PERM = true, AFTER_DRAIN = false;
    bf16_t* O; int ldc;
    __device__ __forceinline__ void operator()(const f32x4 (&acc)[2][2][4][2], const Unit& u, int wr, int wc, int fr, int fq) const {
        const int row0 = u.pm * BM + wr * 64 + fr; const int col0 = u.pn * HALF + wc * 32 + 8 * fq;
#pragma unroll
        for (int ai = 0; ai < 2; ++ai)
#pragma unroll
            for (int m = 0; m < 4; ++m) { bf16_t* rowp = O + (size_t)(row0 + ai * HALF + m * 16) * ldc + col0;
                const f32x4 g0 = acc[ai][0][m][0], g1 = acc[ai][0][m][1], a0 = acc[ai][1][m][0], a1 = acc[ai][1][m][1];
                u32x4 w;
                w.x = cvt_pk_bf16(silu_f(g0[0]) * a0[0], silu_f(g0[1]) * a0[1]); w.y = cvt_pk_bf16(silu_f(g0[2]) * a0[2], silu_f(g0[3]) * a0[3]);
                w.z = cvt_pk_bf16(silu_f(g1[0]) * a1[0], silu_f(g1[1]) * a1[1]); w.w = cvt_pk_bf16(silu_f(g1[2]) * a1[2], silu_f(g1[3]) * a1[3]);
                *(u32x4*)rowp = w; }
    }
};
template <class Epi, class Sched, bool ALIGN_EPI = false, bool SP2 = false>
__device__ __forceinline__ void gemm_phase(PG8_LAS unsigned char* lds, const Gemm g, const Sched& S, const Epi& E) {
    const int tid = threadIdx.x, wid = __builtin_amdgcn_readfirstlane(tid >> 6), lane = tid & 63, wr = wid >> 2, wc = wid & 3, fr = lane & 15, fq = lane >> 4;
    const int K = g.K, nt = K / BK;
    unsigned voffA[2], voffB[2];
#pragma unroll
    for (int i = 0; i < 2; ++i) { int R, C; stage_rc(tid * 16 + i * 8192, R, C); const int Rb = Epi::PERM ? ((R & ~31) + perm32(R & 31)) : R;
        voffA[i] = (unsigned)(R * K + C) * 2u; voffB[i] = (unsigned)(Rb * K + C) * 2u; }
    const size_t kstep = (size_t)(BK * 2);
    const size_t hstep = (size_t)HALF * K * 2;
    const size_t tstep = 2 * hstep;
    const unsigned ldsw = (unsigned)wid * 1024u;
    const int aoff = lds_byte(wr * 64 + fr, fq * 8), boff = lds_byte(wc * 32 + fr, fq * 8);
#define PG8_SA(b, h) (((b) * 2 + (h)) * HTB)
#define PG8_SB(b, h) ((4 + (b) * 2 + (h)) * HTB)
#define PG8_STAGE(bufoff, gbase, voff) do { _Pragma("unroll") for (int _i = 0; _i < 2; ++_i) \
        __builtin_amdgcn_global_load_lds((const unsigned*)((const char*)(gbase) + (voff)[_i]), (PG8_LAS unsigned*)(lds + (bufoff) + ldsw + _i * 8192), 16, 0, 0); } while (0)
#define PG8_LDA(dst, b, h) do { _Pragma("unroll") for (int m = 0; m < 4; ++m) _Pragma("unroll") for (int k = 0; k < 2; ++k) dst[m][k] = *(const PG8_LAS bf16x8*)(lds + PG8_SA(b, h) + aoff + m * 2048 + k * 1024); } while (0)
#define PG8_LDB(dst, b, h) do { _Pragma("unroll") for (int n = 0; n < 2; ++n) _Pragma("unroll") for (int k = 0; k < 2; ++k) dst[n][k] = *(const PG8_LAS bf16x8*)(lds + PG8_SB(b, h) + boff + n * 2048 + k * 1024); } while (0)
#define PG8_MMA(ai, bj, At, Bt) do { __builtin_amdgcn_s_setprio(1); _Pragma("unroll") for (int m = 0; m < 4; ++m) _Pragma("unroll") for (int n = 0; n < 2; ++n) _Pragma("unroll") for (int k = 0; k < 2; ++k) \
        acc[ai][bj][m][n] = __builtin_amdgcn_mfma_f32_16x16x32_bf16(Bt[n][k], At[m][k], acc[ai][bj][m][n], 0, 0, 0); __builtin_amdgcn_s_setprio(0); } while (0)
#define PG8_WAIT_V(n) asm volatile("s_waitcnt vmcnt(" #n ")" ::: "memory")
#define PG8_WAIT_L(n) asm volatile("s_waitcnt lgkmcnt(" #n ")" ::: "memory")
#define PG8_BAR __builtin_amdgcn_s_barrier()
#define PG8_SCHED __builtin_amdgcn_sched_barrier(0)
    Unit cur, nxt; int ui = 0;
    if (!S.next(0, cur)) return;
    f32x4 acc[2][2][4][2];
#pragma unroll
    for (int a = 0; a < 2; ++a)
#pragma unroll
        for (int b = 0; b < 2; ++b)
#pragma unroll
            for (int m = 0; m < 4; ++m)
#pragma unroll
                for (int n = 0; n < 2; ++n) acc[a][b][m][n] = (f32x4){0.f, 0.f, 0.f, 0.f};
    bf16x8 At[4][2], B0[2][2], B1[2][2];
    const char* cA = (const char*)g.A + (size_t)cur.pm * tstep; const char* cB = (const char*)g.Bt + (size_t)cur.pn * tstep;
    S.a_ready(cur);
    if constexpr (SP2) {
        PG8_STAGE(PG8_SB(0, 0), cB, voffB); PG8_STAGE(PG8_SB(0, 1), cB + hstep, voffB); PG8_STAGE(PG8_SA(0, 0), cA, voffA); PG8_STAGE(PG8_SA(0, 1), cA + hstep, voffA);
        if (wr == 1) PG8_BAR;
        PG8_WAIT_V(2); PG8_BAR;
        PG8_STAGE(PG8_SB(1, 0), cB + kstep, voffB); PG8_STAGE(PG8_SA(1, 0), cA + kstep, voffA); PG8_STAGE(PG8_SB(1, 1), cB + hstep + kstep, voffB);
        PG8_WAIT_V(6); PG8_BAR;
    } else {
        PG8_STAGE(PG8_SB(0, 0), cB, voffB); PG8_STAGE(PG8_SA(0, 0), cA, voffA); PG8_STAGE(PG8_SB(0, 1), cB + hstep, voffB); PG8_STAGE(PG8_SA(0, 1), cA + hstep, voffA);
        if (wr == 1) PG8_BAR;
        PG8_WAIT_V(4); PG8_BAR;
        PG8_STAGE(PG8_SB(1, 0), cB + kstep, voffB); PG8_STAGE(PG8_SA(1, 0), cA + kstep, voffA); PG8_STAGE(PG8_SB(1, 1), cB + hstep + kstep, voffB);
        PG8_WAIT_V(6); PG8_BAR;
    }
    for (;;) {
        const bool has_next = S.next(ui + 1, nxt);
        const char* nA = has_next ? (const char*)g.A + (size_t)nxt.pm * tstep : cA; const char* nB = has_next ? (const char*)g.Bt + (size_t)nxt.pn * tstep : cB;
        for (int t = 0; t < nt; t += 2) {
            const bool last = (t == nt - 2);
            const char* a1 = cA + (size_t)(t + 1) * kstep;
            const char* a2 = last ? nA : cA + (size_t)(t + 2) * kstep; const char* b2 = last ? nB : cB + (size_t)(t + 2) * kstep;
            const char* a3 = a2 + kstep; const char* b3 = b2 + kstep;
            if (last && has_next) S.a_ready(nxt);
            if constexpr (SP2) {
            PG8_LDB(B0, 0, 0); PG8_LDB(B1, 0, 1); PG8_SCHED; PG8_LDA(At, 0, 0); PG8_STAGE(PG8_SA(1, 1), a1 + hstep, voffA);
            PG8_WAIT_V(8); PG8_WAIT_L(0); PG8_BAR; PG8_MMA(0, 0, At, B0); PG8_MMA(0, 1, At, B1); PG8_BAR; PG8_SCHED;
            PG8_LDA(At, 0, 1); PG8_STAGE(PG8_SB(0, 0), b2, voffB); PG8_STAGE(PG8_SB(0, 1), b2 + hstep, voffB); PG8_STAGE(PG8_SA(0, 0), a2, voffA);
            PG8_WAIT_V(8); PG8_WAIT_L(0); PG8_BAR; PG8_MMA(1, 0, At, B0); PG8_MMA(1, 1, At, B1); PG8_BAR; PG8_SCHED;
            PG8_LDB(B0, 1, 0); PG8_LDB(B1, 1, 1); PG8_SCHED; PG8_LDA(At, 1, 0); PG8_STAGE(PG8_SA(0, 1), a2 + hstep, voffA);
            PG8_WAIT_V(8); PG8_WAIT_L(0); PG8_BAR; PG8_MMA(0, 0, At, B0); PG8_MMA(0, 1, At, B1); PG8_BAR; PG8_SCHED;
            PG8_LDA(At, 1, 1); PG8_STAGE(PG8_SB(1, 0), b3, voffB); PG8_STAGE(PG8_SB(1, 1), b3 + hstep, voffB); PG8_STAGE(PG8_SA(1, 0), a3, voffA);
            PG8_WAIT_V(8); PG8_WAIT_L(0); PG8_BAR; PG8_MMA(1, 0, At, B0); PG8_MMA(1, 1, At, B1); PG8_BAR; PG8_SCHED;
            } else {
            PG8_LDB(B0, 0, 0); PG8_SCHED; PG8_LDA(At, 0, 0); PG8_STAGE(PG8_SA(1, 1), a1 + hstep, voffA);
            PG8_WAIT_L(8); PG8_BAR; PG8_WAIT_L(0); PG8_MMA(0, 0, At, B0); PG8_BAR; PG8_SCHED;
            PG8_LDB(B1, 0, 1); PG8_STAGE(PG8_SB(0, 0), b2, voffB);
            PG8_BAR; PG8_WAIT_L(0); PG8_MMA(0, 1, At, B1); PG8_BAR;
            PG8_LDA(At, 0, 1); PG8_STAGE(PG8_SA(0, 0), a2, voffA);
            PG8_BAR; PG8_WAIT_L(0); PG8_MMA(1, 0, At, B0); PG8_BAR; PG8_SCHED;
            PG8_STAGE(PG8_SB(0, 1), b2 + hstep, voffB);
            PG8_WAIT_V(6); PG8_BAR; PG8_MMA(1, 1, At, B1); PG8_BAR;
            PG8_LDB(B0, 1, 0); PG8_SCHED; PG8_LDA(At, 1, 0); PG8_STAGE(PG8_SA(0, 1), a2 + hstep, voffA);
            PG8_WAIT_L(8); PG8_BAR; PG8_WAIT_L(0); PG8_MMA(0, 0, At, B0); PG8_BAR; PG8_SCHED;
            PG8_LDB(B1, 1, 1); PG8_STAGE(PG8_SB(1, 0), b3, voffB);
            PG8_BAR; PG8_WAIT_L(0); PG8_MMA(0, 1, At, B1); PG8_BAR;
            PG8_LDA(At, 1, 1); PG8_STAGE(PG8_SA(1, 0), a3, voffA);
            PG8_BAR; PG8_WAIT_L(0); PG8_MMA(1, 0, At, B0); PG8_BAR; PG8_SCHED;
            PG8_STAGE(PG8_SB(1, 1), b3 + hstep, voffB);
            PG8_WAIT_V(6); PG8_BAR; PG8_MMA(1, 1, At, B1); PG8_BAR;
            }
        }
        if constexpr (ALIGN_EPI) { if (wr == 0) PG8_BAR; }
        if constexpr (!Epi::AFTER_DRAIN) { E(acc, cur, wr, wc, fr, fq); S.done(cur); }
        if (!has_next) break;
#pragma unroll
        for (int a = 0; a < 2; ++a)
#pragma unroll
            for (int b = 0; b < 2; ++b)
#pragma unroll
                for (int m = 0; m < 4; ++m)
#pragma unroll
                    for (int n = 0; n < 2; ++n) acc[a][b][m][n] = (f32x4){0.f, 0.f, 0.f, 0.f};
        cur = nxt; cA = nA; cB = nB; ++ui;
        if constexpr (ALIGN_EPI) { if (wr == 1) PG8_BAR; }
    }
    PG8_WAIT_V(0);
    if constexpr (!ALIGN_EPI) { if (wr == 0) PG8_BAR; }
    PG8_BAR;
    if constexpr (Epi::AFTER_DRAIN) { E.fused(acc, cur, wr, wc, fr, fq, lds, wid, lane); S.done(cur); }
#undef PG8_SA
#undef PG8_SB
#undef PG8_STAGE
#undef PG8_LDA
#undef PG8_LDB
#undef PG8_MMA
#undef PG8_WAIT_V
#undef PG8_WAIT_L
#undef PG8_BAR
#undef PG8_SCHED
}
}

constexpr int NWAVES = 8, NTHR = NWAVES * 64;
constexpr int DM = 1024, NB = 16, SEQ = 2048, CTXL = 256;
constexpr int ML = NB * SEQ;
constexpr int MC = NB * CTXL;
constexpr int MT = ML + MC;
constexpr int NP = 2048;
constexpr int INW = 2064;
constexpr int DFF = 2816;
constexpr int NHEAD = 4, DK = 64, DV = 128;
constexpr float EPS = 1e-6f;
constexpr int NMOD = 6 * DM;
constexpr int ADA_KB = 16;

constexpr size_t MiB = 1u << 20;
constexpr size_t WS_CTL = 0;
constexpr size_t WS_MODP = 1 * MiB;
constexpr size_t WS_MOD = 8 * MiB;
constexpr size_t WS_WG = 9 * MiB;
constexpr size_t WS_POOLW = 9 * MiB + 512 * 1024;
constexpr size_t WS_WIN = 10 * MiB;
constexpr size_t WS_WOUT = 14 * MiB;
constexpr size_t WS_WUP = 16 * MiB;
constexpr size_t WS_WDN = 27 * MiB;
constexpr size_t WS_GATES = 33 * MiB;
constexpr size_t WS_HX = 36 * MiB;
constexpr size_t WS_P = 108 * MiB;
constexpr size_t WS_QK = 252 * MiB;
constexpr size_t WS_HID = WS_P;
constexpr size_t WS_MIX = 288 * MiB;
constexpr size_t WS_HF = 352 * MiB;
constexpr size_t WS_HB = 416 * MiB;
constexpr size_t WS_END = 480 * MiB;
static_assert(WS_HID + (size_t)ML * DFF * 2 <= WS_MIX, "hidden overlay");

constexpr int LDS_BYTES = 147456;
constexpr int RING_BYTES = 131072;

#define GAS __attribute__((address_space(1)))
#define LAS __attribute__((address_space(3)))
typedef unsigned short bf16;
typedef float f32x4 __attribute__((ext_vector_type(4)));
typedef float f32x2 __attribute__((ext_vector_type(2)));
typedef unsigned u32x4 __attribute__((ext_vector_type(4)));
typedef unsigned u32x2 __attribute__((ext_vector_type(2)));
#define LDS_WAIT() asm volatile("s_waitcnt lgkmcnt(0)" ::: "memory")

__device__ __forceinline__ float bf2f(unsigned short b) { return __uint_as_float((unsigned)b << 16); }
__device__ __forceinline__ float bflo(unsigned w) { return __uint_as_float(w << 16); }
__device__ __forceinline__ float bfhi(unsigned w) { return __uint_as_float(w & 0xffff0000u); }
__device__ __forceinline__ unsigned pk2(float lo, float hi) { return pg8::cvt_pk_bf16(lo, hi); }
__device__ __forceinline__ float wave_sum(float v) {
#pragma unroll
    for (int o = 1; o < 64; o <<= 1) v += __shfl_xor(v, o);
    return v;
}
__device__ __forceinline__ float silu_acc(float x) { return x / (1.0f + __expf(-x)); }

struct Args {
    const float *x, *c, *ctx, *c_ctx, *w_ada, *b_ada, *norm1, *w_in, *conv_qk, *gate_bias, *pool_w, *pool_scale, *head_norm, *w_out, *norm2, *w_up, *w_down, *norm_f;
    float* out; unsigned char* ws; int ph_lo, ph_hi;
};

__device__ __forceinline__ void tr_item(const float* W, int ldw, bf16* WT, int K, int k0, int n0, int drow0, LAS float* scr, int lane) {
#pragma unroll 8
    for (int i = 0; i < 32; ++i) { const int kk = 2 * i + (lane >> 5); scr[kk * 33 + (lane & 31)] = W[(size_t)(k0 + kk) * ldw + n0 + (lane & 31)]; }
    LDS_WAIT(); asm volatile("" ::: "memory");
    const int c = lane & 7;
#pragma unroll
    for (int j = 0; j < 4; ++j) { const int n = (lane >> 3) + 8 * j; const LAS float* s = scr + (8 * c) * 33 + n;
        u32x4 o; o.x = pk2(s[0 * 33], s[1 * 33]); o.y = pk2(s[2 * 33], s[3 * 33]); o.z = pk2(s[4 * 33], s[5 * 33]); o.w = pk2(s[6 * 33], s[7 * 33]);
        *(u32x4*)(WT + (size_t)(drow0 + n) * K + k0 + 8 * c) = o; }
    LDS_WAIT(); asm volatile("" ::: "memory");
}
__device__ __forceinline__ void phase0(const Args& a, LAS unsigned char* lds, int G) {
    const int tid = threadIdx.x, lane = tid & 63, wave = __builtin_amdgcn_readfirstlane(tid >> 6);
    LAS float* scr = (LAS float*)(lds + wave * 16384);
    const int gw = blockIdx.x * NWAVES + wave, NGW = G * NWAVES;
    unsigned char* ws = a.ws;
    bf16* win_t = (bf16*)(ws + WS_WIN); bf16* wout_t = (bf16*)(ws + WS_WOUT); bf16* wup_t = (bf16*)(ws + WS_WUP); bf16* wdn_t = (bf16*)(ws + WS_WDN); bf16* poolw_t = (bf16*)(ws + WS_POOLW);
    constexpr int I_IN = 16 * 64, I_OUT = 16 * 32, I_UP = 16 * 176, I_DN = 44 * 32, I_PW = 32, I_ADA = 24 * ADA_KB;
    constexpr int NITEMS = I_ADA + I_IN + I_OUT + I_UP + I_DN + I_PW;
    for (int it = gw; it < NITEMS; it += NGW) {
        int r = it;
        if (r < I_ADA) {
            const int cb = r / ADA_KB, kb = r % ADA_KB, k0 = kb * 64, col = cb * 256 + lane * 4;
            for (int idx = lane; idx < 17 * 64; idx += 64) { const int rr = idx >> 6, kk = idx & 63; const float cv = rr < 16 ? a.c[rr * DM + k0 + kk] : a.c_ctx[k0 + kk]; scr[idx] = silu_acc(cv); }
            LDS_WAIT(); asm volatile("" ::: "memory");
            f32x4 acc[17];
#pragma unroll
            for (int rr = 0; rr < 17; ++rr) acc[rr] = (f32x4){0.f, 0.f, 0.f, 0.f};
            for (int kk = 0; kk < 64; ++kk) { const f32x4 w = *(const f32x4*)(a.w_ada + (size_t)(k0 + kk) * NMOD + col);
#pragma unroll
                for (int rr = 0; rr < 17; ++rr) acc[rr] += scr[rr * 64 + kk] * w; }
            if (kb == 0) { const f32x4 bv = *(const f32x4*)(a.b_ada + col);
#pragma unroll
                for (int rr = 0; rr < 17; ++rr) acc[rr] += bv; }
            float* mp = (float*)(ws + WS_MODP) + (size_t)kb * 17 * NMOD + col;
#pragma unroll
            for (int rr = 0; rr < 17; ++rr) *(f32x4*)(mp + (size_t)rr * NMOD) = acc[rr];
            LDS_WAIT(); asm volatile("" ::: "memory");
            continue; }
        r -= I_ADA;
        if (r < I_IN) { const int kb = r / 64, nb = r % 64; tr_item(a.w_in, INW, win_t, DM, kb * 64, nb * 32, nb * 32, scr, lane); continue; } r -= I_IN;
        if (r < I_OUT) { const int kb = r / 32, nb = r % 32; tr_item(a.w_out, DM, wout_t, DM, kb * 64, nb * 32, nb * 32, scr, lane); continue; } r -= I_OUT;
        if (r < I_UP) { const int kb = r / 176, nb = r % 176; const int c0 = nb * 32; int drow0;
            if (c0 < DFF) drow0 = 256 * (c0 / 128) + (c0 % 128); else { const int c1 = c0 - DFF; drow0 = 256 * (c1 / 128) + 128 + (c1 % 128); }
            tr_item(a.w_up, 2 * DFF, wup_t, DM, kb * 64, c0, drow0, scr, lane); continue; } r -= I_UP;
        if (r < I_DN) { const int kb = r / 32, nb = r % 32; tr_item(a.w_down, DM, wdn_t, DFF, kb * 64, nb * 32, nb * 32, scr, lane); continue; } r -= I_DN;
        { const int g = r / 8, q = r % 8, kb = q / 4, nb = q % 4; tr_item(a.pool_w + g * 16384, 128, poolw_t + g * 16384, 128, kb * 64, nb * 32, nb * 32, scr, lane); }
    }
    float* wg = (float*)(ws + WS_WG);
    for (int idx = blockIdx.x * NTHR + tid; idx < 16 * DM; idx += G * NTHR) { const int k = idx >> 4, j = idx & 15; wg[j * DM + k] = a.w_in[(size_t)k * INW + 2048 + j]; }
}

__device__ __forceinline__ float logsigmoid_f(float v) { return fminf(v, 0.f) - log1pf(__expf(-fabsf(v))); }
__device__ __forceinline__ float reduce16(float (&v)[16], int lane) {
    { const bool up = (lane & 32) != 0;
#pragma unroll
      for (int j = 0; j < 8; ++j) { const float send = up ? v[j] : v[j + 8]; const float keep = up ? v[j + 8] : v[j]; v[j] = keep + __shfl_xor(send, 32); } }
    { const bool up = (lane & 16) != 0;
#pragma unroll
      for (int j = 0; j < 4; ++j) { const float send = up ? v[j] : v[j + 4]; const float keep = up ? v[j + 4] : v[j]; v[j] = keep + __shfl_xor(send, 16); } }
    { const bool up = (lane & 8) != 0;
#pragma unroll
      for (int j = 0; j < 2; ++j) { const float send = up ? v[j] : v[j + 2]; const float keep = up ? v[j + 2] : v[j]; v[j] = keep + __shfl_xor(send, 8); } }
    { const bool up = (lane & 4) != 0; const float send = up ? v[0] : v[1]; const float keep = up ? v[1] : v[0]; v[0] = keep + __shfl_xor(send, 4); }
    float s = v[0]; s += __shfl_xor(s, 1); s += __shfl_xor(s, 2); return s;
}
__device__ __forceinline__ void p1_pair(const Args& a, const float* xr0, const float* xr1, int orow0, int orow1, const LAS float* S, const LAS float* H, const LAS float* WgL, int lane) {
    bf16* hx = (bf16*)(a.ws + WS_HX); float* gates = (float*)(a.ws + WS_GATES);
    float s0 = 0.f, s1 = 0.f;
#pragma unroll
    for (int j = 0; j < 4; ++j) { const f32x4 v0 = *(const f32x4*)(xr0 + 4 * lane + 256 * j), v1 = *(const f32x4*)(xr1 + 4 * lane + 256 * j);
        s0 += (v0.x * v0.x + v0.y * v0.y) + (v0.z * v0.z + v0.w * v0.w); s1 += (v1.x * v1.x + v1.y * v1.y) + (v1.z * v1.z + v1.w * v1.w); }
    const float r0 = rsqrtf(wave_sum(s0) * (1.f / DM) + EPS), r1 = rsqrtf(wave_sum(s1) * (1.f / DM) + EPS);
    float g0[16], g1[16];
#pragma unroll
    for (int g = 0; g < 16; ++g) { g0[g] = 0.f; g1[g] = 0.f; }
#pragma unroll 1
    for (int j = 0; j < 4; ++j) { const int k = 4 * lane + 256 * j;
        const f32x4 v0 = *(const f32x4*)(xr0 + k), v1 = *(const f32x4*)(xr1 + k);
        const f32x4 sv = *(const LAS f32x4*)(S + k), hv = *(const LAS f32x4*)(H + k);
        const f32x4 h0 = (v0 * r0) * sv + hv, h1 = (v1 * r1) * sv + hv;
        u32x2 w0, w1; w0.x = pk2(h0.x, h0.y); w0.y = pk2(h0.z, h0.w); w1.x = pk2(h1.x, h1.y); w1.y = pk2(h1.z, h1.w);
        *(u32x2*)(hx + (size_t)orow0 * DM + k) = w0; *(u32x2*)(hx + (size_t)orow1 * DM + k) = w1;
#pragma unroll
        for (int g = 0; g < 16; ++g) { const f32x4 wv = *(const LAS f32x4*)(WgL + g * DM + k);
            g0[g] += (h0.x * wv.x + h0.y * wv.y) + (h0.z * wv.z + h0.w * wv.w); g1[g] += (h1.x * wv.x + h1.y * wv.y) + (h1.z * wv.z + h1.w * wv.w); } }
    const float t0 = reduce16(g0, lane), t1 = reduce16(g1, lane);
    if ((lane & 3) == 0) { const int g = ((lane >> 5) & 1) * 8 + ((lane >> 4) & 1) * 4 + ((lane >> 3) & 1) * 2 + ((lane >> 2) & 1);
        const float bias = a.gate_bias[g]; float y0 = t0 + bias, y1 = t1 + bias;
        if (g >= 8) { y0 = logsigmoid_f(y0); y1 = logsigmoid_f(y1); }
        gates[(size_t)orow0 * 16 + g] = y0; gates[(size_t)orow1 * 16 + g] = y1; }
}
__device__ __forceinline__ void phase1(const Args& a, LAS unsigned char* lds, int G) {
    const int tid = threadIdx.x, lane = tid & 63, wave = __builtin_amdgcn_readfirstlane(tid >> 6);
    LAS float* S1 = (LAS float*)lds; LAS float* H1 = S1 + DM; LAS float* S1c = H1 + DM; LAS float* H1c = S1c + DM; LAS float* WgL = H1c + DM;
    const float* modp = (const float*)(a.ws + WS_MODP); float* mod = (float*)(a.ws + WS_MOD); const float* wg = (const float*)(a.ws + WS_WG);
    for (int rg = blockIdx.x; rg < 256; rg += G) {
        const int b = rg >> 4, sub = rg & 15;
        __syncthreads();
#pragma unroll 1
        for (int idx = tid; idx < DM; idx += NTHR) { float sh = 0.f, sc = 0.f, shc = 0.f, scc = 0.f;
#pragma unroll 4
            for (int kb = 0; kb < ADA_KB; ++kb) { const float* p = modp + (size_t)kb * 17 * NMOD; sh += p[b * NMOD + idx]; sc += p[b * NMOD + DM + idx]; shc += p[16 * NMOD + idx]; scc += p[16 * NMOD + DM + idx]; }
            const float n1 = a.norm1[idx]; S1[idx] = n1 * (1.f + sc); H1[idx] = sh; S1c[idx] = n1 * (1.f + scc); H1c[idx] = shc; }
        if (sub == 0)
#pragma unroll 1
          for (int idx = tid; idx < NMOD; idx += NTHR) { float s = 0.f;
#pragma unroll 4
            for (int kb = 0; kb < ADA_KB; ++kb) s += modp[(size_t)kb * 17 * NMOD + b * NMOD + idx]; mod[b * NMOD + idx] = s; }
#pragma unroll 2
        for (int idx = tid; idx < 16 * DM / 4; idx += NTHR) *(LAS f32x4*)(WgL + 4 * idx) = *(const f32x4*)(wg + 4 * idx);
        __syncthreads();
        const int lr0 = b * SEQ + sub * 128 + wave * 16;
#pragma unroll 1
        for (int i = 0; i < 16; i += 2) p1_pair(a, a.x + (size_t)(lr0 + i) * DM, a.x + (size_t)(lr0 + i + 1) * DM, lr0 + i, lr0 + i + 1, S1, H1, WgL, lane);
        const int cr0 = b * CTXL + sub * 16 + wave * 2;
        p1_pair(a, a.ctx + (size_t)cr0 * DM, a.ctx + (size_t)(cr0 + 1) * DM, ML + cr0, ML + cr0 + 1, S1c, H1c, WgL, lane);
    }
}

__device__ __forceinline__ void phase2b(const Args& a, int G) {
    const int tid = threadIdx.x, lane = tid & 63, wave = __builtin_amdgcn_readfirstlane(tid >> 6);
    const int gw = blockIdx.x * NWAVES + wave, NGW = G * NWAVES;
    const bf16* P = (const bf16*)(a.ws + WS_P); bf16* QK = (bf16*)(a.ws + WS_QK);
    const int c0 = lane * 8;
    float w0[8], w1[8], w2[8];
#pragma unroll
    for (int e = 0; e < 8; ++e) { w0[e] = a.conv_qk[c0 + e]; w1[e] = a.conv_qk[512 + c0 + e]; w2[e] = a.conv_qk[1024 + c0 + e]; }
    const float qs = (c0 < 256) ? 0.125f : 1.0f;
    for (int it = gw; it < MT / 16; it += NGW) {
        const int r0 = it * 16;
        const int t0 = (r0 < ML) ? (r0 % SEQ) : ((r0 - ML) % CTXL); const int tlen = (r0 < ML) ? SEQ : CTXL;
        u32x4 prev = (u32x4){0u, 0u, 0u, 0u}, cur, nxt;
        if (t0 != 0) prev = *(const u32x4*)(P + (size_t)(r0 - 1) * NP + 512 + c0);
        cur = *(const u32x4*)(P + (size_t)r0 * NP + 512 + c0);
        for (int i = 0; i < 16; ++i) {
            const bool has_next = (i < 15) || (t0 + 16 != tlen);
            nxt = (u32x4){0u, 0u, 0u, 0u};
            if (has_next) nxt = *(const u32x4*)(P + (size_t)(r0 + i + 1) * NP + 512 + c0);
            float y[8];
#pragma unroll
            for (int e = 0; e < 4; ++e) {
                y[2 * e] = w0[2 * e] * bflo(prev[e]) + w1[2 * e] * bflo(cur[e]) + w2[2 * e] * bflo(nxt[e]);
                y[2 * e + 1] = w0[2 * e + 1] * bfhi(prev[e]) + w1[2 * e + 1] * bfhi(cur[e]) + w2[2 * e + 1] * bfhi(nxt[e]); }
            u32x4 o;
#pragma unroll
            for (int e = 0; e < 4; ++e) o[e] = pk2(silu_acc(y[2 * e]) * qs, silu_acc(y[2 * e + 1]) * qs);
            *(u32x4*)(QK + (size_t)(r0 + i) * 512 + c0) = o;
            prev = cur; cur = nxt;
        }
    }
}

__device__ __forceinline__ void phase3_pool(const Args& a, LAS unsigned char* lds, int G) {
    const int tid = threadIdx.x;
    const bf16* P = (const bf16*)(a.ws + WS_P); bf16* MIX = (bf16*)(a.ws + WS_MIX);
    LAS float* dS = (LAS float*)lds;
    for (int it = blockIdx.x; it < (ML / 64) * 4; it += G) {
        const int tb = it >> 2, g = it & 3, tok0 = tb * 64, half = 1 << g;
        __syncthreads();
        for (int i = 0; i < 16; ++i) { const int idx = tid + NTHR * i, p = idx >> 7, c = idx & 127;
            int lo = p - half; if (lo < 0) lo = 0; int hi = p + half - 1; if (hi > 63) hi = 63;
            float s = 0.f; for (int q = lo; q <= hi; ++q) s += bf2f(P[(size_t)(tok0 + q) * NP + g * 128 + c]);
            dS[p * 128 + c] = s / (float)(hi - lo + 1) - bf2f(P[(size_t)(tok0 + p) * NP + g * 128 + c]); }
        __syncthreads();
        const int n = tid & 127, pq = tid >> 7;
        float acc[16];
#pragma unroll
        for (int i = 0; i < 16; ++i) acc[i] = 0.f;
        const float* W = a.pool_w + g * 16384 + n;
        for (int c = 0; c < 128; ++c) { const float w = W[c * 128];
#pragma unroll
            for (int i = 0; i < 16; ++i) acc[i] += dS[(pq + 4 * i) * 128 + c] * w; }
        const float ps = a.pool_scale[g * 128 + n];
#pragma unroll
        for (int i = 0; i < 16; ++i) { const unsigned w = pk2(acc[i] * ps, 0.f); MIX[(size_t)(tok0 + pq + 4 * i) * DM + g * 128 + n] = (bf16)(w & 0xffffu); }
    }
}

__device__ __forceinline__ void phase3_mlstm(const Args& a, LAS unsigned char* lds, int G) {
    const int tid = threadIdx.x;
    const bf16* P = (const bf16*)(a.ws + WS_P); const bf16* QK = (const bf16*)(a.ws + WS_QK); const float* gates = (const float*)(a.ws + WS_GATES);
    LAS float* qS = (LAS float*)lds; LAS float* kS = qS + 64 * 64; LAS float* vS = kS + 64 * 64; LAS float* igS = vS + 64 * 128; LAS float* lfS = igS + 64;
    const int v = tid >> 2, dq = tid & 3;
    for (int it = blockIdx.x; it < NB * NHEAD * 2; it += G) {
        const int dir = it & 1, hh = (it >> 1) & 3, b = it >> 3;
        float* H = (float*)(a.ws + (dir ? WS_HB : WS_HF));
        float C[16], nn[16]; float m = 0.f;
#pragma unroll
        for (int d = 0; d < 16; ++d) { C[d] = 0.f; nn[d] = 0.f; }
        for (int seg = 0; seg < 2; ++seg) {
            const int tlen = seg ? SEQ : CTXL; const int rbase = seg ? b * SEQ : ML + b * CTXL;
            for (int ch = 0; ch < tlen / 64; ++ch) {
                __syncthreads();
                for (int i = 0; i < 4; ++i) { const int idx = tid + NTHR * i, jj = idx >> 5, cix = idx & 31;
                    const int st = ch * 64 + jj, t = dir ? (tlen - 1 - st) : st; const size_t row = (size_t)(rbase + t);
                    const bf16* src; LAS float* dst;
                    if (cix < 8) { src = QK + row * 512 + hh * 64 + cix * 8; dst = qS + jj * 64 + cix * 8; }
                    else if (cix < 16) { src = QK + row * 512 + 256 + hh * 64 + (cix - 8) * 8; dst = kS + jj * 64 + (cix - 8) * 8; }
                    else { src = P + row * NP + 1024 + hh * 128 + (cix - 16) * 8; dst = vS + jj * 128 + (cix - 16) * 8; }
                    const u32x4 w = *(const u32x4*)src;
#pragma unroll
                    for (int e = 0; e < 4; ++e) { dst[2 * e] = bflo(w[e]); dst[2 * e + 1] = bfhi(w[e]); } }
                if (tid < 64) { const int st = ch * 64 + tid, t = dir ? (tlen - 1 - st) : st; const size_t row = (size_t)(rbase + t);
                    igS[tid] = gates[row * 16 + dir * 4 + hh]; lfS[tid] = gates[row * 16 + 8 + dir * 4 + hh]; }
                __syncthreads();
                for (int jj = 0; jj < 64; ++jj) {
                    const float ig = igS[jj], lf = lfS[jj];
                    const float mn = fmaxf(lf + m, ig), fd = __expf(lf + m - mn), iw = __expf(ig - mn); m = mn;
                    const float vv = vS[jj * 128 + v] * iw;
                    float num = 0.f, den = 0.f;
#pragma unroll
                    for (int d4 = 0; d4 < 4; ++d4) { const f32x4 kk = *(const LAS f32x4*)(kS + jj * 64 + dq * 16 + d4 * 4), qq = *(const LAS f32x4*)(qS + jj * 64 + dq * 16 + d4 * 4);
#pragma unroll
                        for (int e = 0; e < 4; ++e) { const int d = d4 * 4 + e; C[d] = fd * C[d] + vv * kk[e]; nn[d] = fd * nn[d] + iw * kk[e]; num += C[d] * qq[e]; den += nn[d] * qq[e]; } }
                    num += __shfl_xor(num, 1); num += __shfl_xor(num, 2); den += __shfl_xor(den, 1); den += __shfl_xor(den, 2);
                    if (seg && dq == 0) { const int st = ch * 64 + jj, t = dir ? (tlen - 1 - st) : st;
                        H[(size_t)(rbase + t) * 512 + hh * 128 + v] = num / fmaxf(fabsf(den), __expf(-m)); }
                }
            }
        }
    }
}


typedef short bf16x8 __attribute__((ext_vector_type(8)));
typedef short s16x4 __attribute__((ext_vector_type(4)));
typedef short v4i16_t __attribute__((ext_vector_type(4)));
typedef float f32x16 __attribute__((ext_vector_type(16)));
typedef __bf16 bf16x2v __attribute__((ext_vector_type(2)));
__device__ __forceinline__ f32x16 mfma32(bf16x8 a, bf16x8 b, f32x16 c) { return __builtin_amdgcn_mfma_f32_32x32x16_bf16(a, b, c, 0, 0, 0); }
__device__ __forceinline__ bf16x8 pack8(const f32x16& x, int ks) { u32x4 p; p.x = pk2(x[8 * ks], x[8 * ks + 1]); p.y = pk2(x[8 * ks + 2], x[8 * ks + 3]); p.z = pk2(x[8 * ks + 4], x[8 * ks + 5]); p.w = pk2(x[8 * ks + 6], x[8 * ks + 7]); return __builtin_bit_cast(bf16x8, p); }
__device__ __forceinline__ s16x4 tr_read(const LAS unsigned char* p) { return __builtin_bit_cast(s16x4, __builtin_amdgcn_ds_read_tr16_b64_v4i16((LAS v4i16_t*)p)); }
__device__ __forceinline__ bf16x8 cat8(s16x4 lo, s16x4 hi) { return __builtin_shufflevector(lo, hi, 0, 1, 2, 3, 4, 5, 6, 7); }
__device__ __forceinline__ bf16x8 ld_pi(const LAS unsigned char* tile, int row, int ch0, int hf) {
    const int f = (row ^ (row >> 3)) & 7;
    const u32x2 lo = *(const LAS u32x2*)(tile + row * 128 + ((ch0 ^ f) << 4) + 8 * hf), hi = *(const LAS u32x2*)(tile + row * 128 + (((ch0 + 1) ^ f) << 4) + 8 * hf);
    return __builtin_bit_cast(bf16x8, (u32x4){lo.x, lo.y, hi.x, hi.y});
}
__device__ __forceinline__ float dot2bf(unsigned a, unsigned b, float acc) { return __builtin_amdgcn_fdot2_f32_bf16(__builtin_bit_cast(bf16x2v, a), __builtin_bit_cast(bf16x2v, b), acc, false); }
__device__ __forceinline__ void glds16(const void* gsrc, unsigned lds_dst) { unsigned keep;
    asm volatile("s_mov_b32 %0, m0\n\ts_mov_b32 m0, %2\n\ts_nop 0\n\tglobal_load_lds_dwordx4 %1, off\n\ts_mov_b32 m0, %0" : "=&s"(keep) : "v"(gsrc), "s"(lds_dst) : "memory"); }
constexpr int ML_BUF = 20480, ML_VEC = 40960, ML_WAVE_LDS = 49152, ML_LDS0 = 32768, ML_NCH = CTXL / 64 + SEQ / 64;
__device__ __forceinline__ int ml_tokrow(int g, int pos, int dir, int b) {
    const int seg = g >= CTXL / 64, ch = seg ? g - CTXL / 64 : g, tlen = seg ? SEQ : CTXL, rbase = seg ? b * SEQ : ML + b * CTXL;
    const int st = ch * 64 + pos; return rbase + (dir ? (tlen - 1 - st) : st);
}
__device__ __forceinline__ void ml_issue(const bf16* P, const bf16* QK, unsigned dst, int g, int dir, int b, int hh, int vs, int lane) {
#pragma unroll
    for (int i = 0; i < 8; ++i) { const int rl = 8 * i + (lane >> 3), gch = (lane & 7) ^ ((rl ^ (rl >> 3)) & 7); const size_t row = (size_t)ml_tokrow(g, rl, dir, b);
        glds16(QK + row * 512 + hh * 64 + gch * 8, (unsigned)__builtin_amdgcn_readfirstlane(dst + i * 1024));
        glds16(QK + row * 512 + 256 + hh * 64 + gch * 8, (unsigned)__builtin_amdgcn_readfirstlane(dst + 8192 + i * 1024)); }
#pragma unroll
    for (int i = 0; i < 4; ++i) { const int rl = 16 * i + (lane >> 2); const size_t row = (size_t)ml_tokrow(g, rl, dir, b);
        glds16(P + row * NP + 1024 + hh * 128 + vs * 32 + (lane & 3) * 8, (unsigned)__builtin_amdgcn_readfirstlane(dst + 16384 + i * 1024)); }
}
__device__ __forceinline__ void mlstm_task(const Args& a, LAS unsigned char* wl, int tk, int lane) {
    const int vs = tk & 3, dir = (tk >> 2) & 1, hh = (tk >> 3) & 3, b = tk >> 5;
    const int c = lane & 31, hf = lane >> 5;
    const bf16* P = (const bf16*)(a.ws + WS_P); const bf16* QK = (const bf16*)(a.ws + WS_QK); const float* gates = (const float*)(a.ws + WS_GATES);
    float* H = (float*)(a.ws + (dir ? WS_HB : WS_HF));
    const unsigned wl_addr = (unsigned)(size_t)wl;
    LAS float* vec = (LAS float*)(wl + ML_VEC);
    const float L2E = 1.4426950408889634f;
    f32x16 ST0, ST1;
#pragma unroll
    for (int r = 0; r < 16; ++r) { ST0[r] = 0.f; ST1[r] = 0.f; }
    float nv0 = 0.f, nv1 = 0.f, m0 = 0.f;
    vec[320 + lane] = 0.f;
    const int q16 = (lane & 15) >> 2, p16 = lane & 3, blk = (lane >> 4) & 1;
    float ig_n = 0.f, lf_n = 0.f;
#pragma unroll 1
    for (int g = -1; g < ML_NCH; ++g) {
        const int buf = g & 1;
        asm volatile("s_waitcnt vmcnt(0) lgkmcnt(0)" ::: "memory");
        const float ig = ig_n, lf = lf_n;
        if (g + 1 < ML_NCH) {
            int lane_o = lane; asm volatile("" : "+v"(lane_o));
            ml_issue(P, QK, wl_addr + (buf ^ 1) * ML_BUF, g + 1, dir, b, hh, vs, lane_o);
            const size_t row = (size_t)ml_tokrow(g + 1, lane_o, dir, b); ig_n = gates[row * 16 + dir * 4 + hh]; lf_n = gates[row * 16 + 8 + dir * 4 + hh];
        }
        if (g < 0) continue;
        const bool want_h = g >= CTXL / 64;
        const LAS unsigned char* Qt = wl + buf * ML_BUF; const LAS unsigned char* Kt = Qt + 8192; const LAS unsigned char* Vt = Qt + 16384;
        float bsum = lf;
#pragma unroll
        for (int off = 1; off < 64; off <<= 1) { const float t = __shfl_up(bsum, off); if (lane >= off) bsum += t; }
        const float av = ig - bsum;
        float cm = av;
#pragma unroll
        for (int off = 1; off < 64; off <<= 1) { const float t = __shfl_up(cm, off); if (lane >= off) cm = fmaxf(cm, t); }
        const float M = fmaxf(m0, cm);
        const float bl = __shfl(bsum, 63), M63 = __shfl(M, 63);
        const float a2 = av * L2E, M2 = M * L2E, m02 = m0 * L2E, M632 = M63 * L2E;
        const float decay = __builtin_amdgcn_exp2f(m02 - M632);
        vec[256 + lane] = __builtin_amdgcn_exp2f(a2 - M632);
        if (want_h) { vec[lane] = a2; vec[64 + lane] = M2; vec[128 + lane] = __builtin_amdgcn_exp2f(m02 - M2); vec[192 + lane] = __builtin_amdgcn_exp2f(-(bsum * L2E + M2)); }
        if (want_h) {
            bf16x8 Qf[2][2][2];
#pragma unroll
            for (int jt = 0; jt < 2; ++jt)
#pragma unroll
                for (int dt = 0; dt < 2; ++dt)
#pragma unroll
                    for (int ks = 0; ks < 2; ++ks) Qf[jt][dt][ks] = ld_pi(Qt, 32 * jt + c, 4 * dt + 2 * ks, hf);
            f32x16 S00, S01, S11;
            int c_k = c; asm volatile("" : "+v"(c_k));
#pragma unroll
            for (int r = 0; r < 16; ++r) { S00[r] = 0.f; S01[r] = 0.f; S11[r] = 0.f; }
#pragma unroll
            for (int dt = 0; dt < 2; ++dt)
#pragma unroll
                for (int ks = 0; ks < 2; ++ks) { const bf16x8 k0 = ld_pi(Kt, c_k, 4 * dt + 2 * ks, hf), k1 = ld_pi(Kt, 32 + c_k, 4 * dt + 2 * ks, hf);
                    S00 = mfma32(k0, Qf[0][dt][ks], S00); S01 = mfma32(k0, Qf[1][dt][ks], S01); S11 = mfma32(k1, Qf[1][dt][ks], S11); }
            __builtin_amdgcn_sched_barrier(0);
            f32x16 Y0, Y1;
#pragma unroll
            for (int r = 0; r < 16; ++r) { Y0[r] = 0.f; Y1[r] = 0.f; }
#pragma unroll
            for (int ks = 0; ks < 2; ++ks) { const bf16x8 s0 = pack8(ST0, ks), s1 = pack8(ST1, ks);
                Y0 = mfma32(s0, Qf[0][0][ks], Y0); Y1 = mfma32(s0, Qf[1][0][ks], Y1); Y0 = mfma32(s1, Qf[0][1][ks], Y0); Y1 = mfma32(s1, Qf[1][1][ks], Y1); }
            __builtin_amdgcn_sched_barrier(0);
            float qn0 = 0.f, qn1 = 0.f;
#pragma unroll
            for (int dt = 0; dt < 2; ++dt)
#pragma unroll
                for (int ks = 0; ks < 2; ++ks) { const u32x4 x0 = __builtin_bit_cast(u32x4, Qf[0][dt][ks]), x1 = __builtin_bit_cast(u32x4, Qf[1][dt][ks]);
                    const f32x4 lo = *(const LAS f32x4*)(vec + 320 + 32 * dt + 16 * ks + 4 * hf), hi = *(const LAS f32x4*)(vec + 320 + 32 * dt + 16 * ks + 8 + 4 * hf);
                    const u32x4 np = (u32x4){pk2(lo.x, lo.y), pk2(lo.z, lo.w), pk2(hi.x, hi.y), pk2(hi.z, hi.w)};
#pragma unroll
                    for (int w = 0; w < 4; ++w) { qn0 = dot2bf(x0[w], np[w], qn0); qn1 = dot2bf(x1[w], np[w], qn1); } }
            qn0 += __shfl_xor(qn0, 32); qn1 += __shfl_xor(qn1, 32);
            __builtin_amdgcn_sched_barrier(0);
            const float M2j0 = vec[64 + c], M2j1 = vec[96 + c], w0 = vec[128 + c], w1 = vec[160 + c], thr0 = vec[192 + c], thr1 = vec[224 + c];
            float den0 = 0.f, den1 = 0.f;
#pragma unroll
            for (int q4 = 0; q4 < 4; ++q4) { const f32x4 a0 = *(const LAS f32x4*)(vec + 8 * q4 + 4 * hf), a1 = *(const LAS f32x4*)(vec + 32 + 8 * q4 + 4 * hf);
#pragma unroll
                for (int e = 0; e < 4; ++e) { const int r = 4 * q4 + e; const int sl = e + 8 * q4 + 4 * hf;
                    float x00 = S00[r] * __builtin_amdgcn_exp2f(a0[e] - M2j0); x00 = (sl <= c) ? x00 : 0.f; den0 += x00; S00[r] = x00;
                    const float x01 = S01[r] * __builtin_amdgcn_exp2f(a0[e] - M2j1); den1 += x01; S01[r] = x01;
                    float x11 = S11[r] * __builtin_amdgcn_exp2f(a1[e] - M2j1); x11 = (sl <= c) ? x11 : 0.f; den1 += x11; S11[r] = x11; } }
            __builtin_amdgcn_sched_barrier(0);
            den0 += __shfl_xor(den0, 32); den1 += __shfl_xor(den1, 32);
            den0 += w0 * qn0; den1 += w1 * qn1;
            const float rinv0 = 1.0f / fmaxf(fabsf(den0), thr0), rinv1 = 1.0f / fmaxf(fabsf(den1), thr1);
#pragma unroll
            for (int r = 0; r < 16; ++r) { Y0[r] *= w0; Y1[r] *= w1; }
            bf16x8 Vf[2][2];
#pragma unroll
            for (int st = 0; st < 2; ++st)
#pragma unroll
                for (int ks = 0; ks < 2; ++ks) { const int row = 32 * st + 16 * ks + 4 * hf + q16; const LAS unsigned char* pp = Vt + row * 64 + blk * 32 + p16 * 8;
                    Vf[st][ks] = cat8(tr_read(pp), tr_read(pp + 8 * 64)); }
#pragma unroll
            for (int ks = 0; ks < 2; ++ks) { Y0 = mfma32(Vf[0][ks], pack8(S00, ks), Y0); Y1 = mfma32(Vf[0][ks], pack8(S01, ks), Y1); Y1 = mfma32(Vf[1][ks], pack8(S11, ks), Y1); }
            __builtin_amdgcn_sched_barrier(0);
            float* h0 = H + (size_t)ml_tokrow(g, c, dir, b) * 512 + hh * 128 + vs * 32 + 4 * hf;
            float* h1 = H + (size_t)ml_tokrow(g, 32 + c, dir, b) * 512 + hh * 128 + vs * 32 + 4 * hf;
#pragma unroll
            for (int q4 = 0; q4 < 4; ++q4) { *(f32x4*)(h0 + 8 * q4) = (f32x4){Y0[4 * q4] * rinv0, Y0[4 * q4 + 1] * rinv0, Y0[4 * q4 + 2] * rinv0, Y0[4 * q4 + 3] * rinv0};
                *(f32x4*)(h1 + 8 * q4) = (f32x4){Y1[4 * q4] * rinv1, Y1[4 * q4 + 1] * rinv1, Y1[4 * q4 + 2] * rinv1, Y1[4 * q4 + 3] * rinv1}; }
        }
        __builtin_amdgcn_sched_barrier(0);
        float np0 = 0.f, np1 = 0.f;
#pragma unroll
        for (int r = 0; r < 16; ++r) { ST0[r] *= decay; ST1[r] *= decay; }
#pragma unroll
        for (int st = 0; st < 2; ++st)
#pragma unroll
            for (int ks = 0; ks < 2; ++ks) {
                const f32x4 wlo = *(const LAS f32x4*)(vec + 256 + 32 * st + 16 * ks + 4 * hf), whi = *(const LAS f32x4*)(vec + 256 + 32 * st + 16 * ks + 8 + 4 * hf);
                const int vrow = 32 * st + 16 * ks + 4 * hf + q16; const LAS unsigned char* vpp = Vt + vrow * 64 + blk * 32 + p16 * 8;
                const u32x4 vw = __builtin_bit_cast(u32x4, cat8(tr_read(vpp), tr_read(vpp + 8 * 64)));
                u32x4 sw; sw.x = pk2(bflo(vw.x) * wlo.x, bfhi(vw.x) * wlo.y); sw.y = pk2(bflo(vw.y) * wlo.z, bfhi(vw.y) * wlo.w); sw.z = pk2(bflo(vw.z) * whi.x, bfhi(vw.z) * whi.y); sw.w = pk2(bflo(vw.w) * whi.z, bfhi(vw.w) * whi.w);
                const bf16x8 Vw = __builtin_bit_cast(bf16x8, sw);
                const u32x4 wkp = (u32x4){pk2(wlo.x, wlo.y), pk2(wlo.z, wlo.w), pk2(whi.x, whi.y), pk2(whi.z, whi.w)};
                int q16o = q16; asm volatile("" : "+v"(q16o));
                const int row = 32 * st + 16 * ks + 4 * hf + q16o; const int f0 = (row ^ (row >> 3)) & 7, f1 = ((row + 8) ^ ((row + 8) >> 3)) & 7;
#pragma unroll
                for (int dt = 0; dt < 2; ++dt) { const int ch = 4 * dt + 2 * blk + (p16 >> 1);
                    const bf16x8 kt = cat8(tr_read(Kt + row * 128 + ((ch ^ f0) << 4) + (p16 & 1) * 8), tr_read(Kt + (row + 8) * 128 + ((ch ^ f1) << 4) + (p16 & 1) * 8));
                    const u32x4 kw = __builtin_bit_cast(u32x4, kt);
                    if (dt == 0) { ST0 = mfma32(kt, Vw, ST0);
#pragma unroll
                        for (int w = 0; w < 4; ++w) np0 = dot2bf(kw[w], wkp[w], np0); }
                    else { ST1 = mfma32(kt, Vw, ST1);
#pragma unroll
                        for (int w = 0; w < 4; ++w) np1 = dot2bf(kw[w], wkp[w], np1); } }
                __builtin_amdgcn_sched_barrier(0);
            }
        np0 += __shfl_xor(np0, 32); np1 += __shfl_xor(np1, 32);
        nv0 = decay * nv0 + np0; nv1 = decay * nv1 + np1;
        vec[320 + lane] = hf ? nv1 : nv0;
        m0 = bl + M63;
    }
}

template <int HALF> __device__ __forceinline__ void pool_d_tile(const bf16* Pg, LAS unsigned char* dtile, int lane) {
    unsigned u[64];
#pragma unroll
    for (int p = 0; p < 64; ++p) u[p] = *(const unsigned*)(Pg + (size_t)p * NP + 2 * lane);
    float s0 = 0.f, s1 = 0.f;
#pragma unroll
    for (int q = 0; q < HALF - 1; ++q) { s0 += bflo(u[q]); s1 += bfhi(u[q]); }
    const int a_l = lane >> 2, sub = (lane & 3) * 4;
#pragma unroll
    for (int p = 0; p < 64; ++p) {
        const int ent = p + HALF - 1, lev = p - HALF - 1;
        if (ent <= 63) { s0 += bflo(u[ent]); s1 += bfhi(u[ent]); }
        if (lev >= 0) { s0 -= bflo(u[lev]); s1 -= bfhi(u[lev]); }
        const int lo = (p - HALF) < 0 ? 0 : (p - HALF), hi = (p + HALF - 1) > 63 ? 63 : (p + HALF - 1);
        const float inv = 1.0f / (float)(hi - lo + 1);
        *(LAS unsigned*)(dtile + p * 256 + ((a_l ^ (p & 15)) << 4) + sub) = pk2(s0 * inv - bflo(u[p]), s1 * inv - bfhi(u[p]));
    }
}
__device__ __forceinline__ void phase3_pool_fast(const Args& a, LAS unsigned char* lds, int G) {
    const int tid = threadIdx.x, lane = tid & 63, wave = __builtin_amdgcn_readfirstlane(tid >> 6);
    const int gw = blockIdx.x * NWAVES + wave, NGW = G * NWAVES;
    const bf16* P = (const bf16*)(a.ws + WS_P); bf16* MIX = (bf16*)(a.ws + WS_MIX); const bf16* poolw_t = (const bf16*)(a.ws + WS_POOLW);
    LAS unsigned char* dtile = lds + wave * 16384;
    const int c = lane & 31, hf = lane >> 5;
    for (int it = gw; it < (ML / 64) * 4; it += NGW) {
        const int tb = it >> 2, g = it & 3, tok0 = tb * 64;
        const bf16* Pg = P + (size_t)tok0 * NP + g * 128;
        if (g == 0) pool_d_tile<1>(Pg, dtile, lane); else if (g == 1) pool_d_tile<2>(Pg, dtile, lane); else if (g == 2) pool_d_tile<4>(Pg, dtile, lane); else pool_d_tile<8>(Pg, dtile, lane);
        bf16x8 Bf[2][8];
#pragma unroll
        for (int pt = 0; pt < 2; ++pt)
#pragma unroll
            for (int ks = 0; ks < 8; ++ks) { const int row = 32 * pt + c; Bf[pt][ks] = *(const LAS bf16x8*)(dtile + row * 256 + (((2 * ks + hf) ^ (row & 15)) << 4)); }
        const bf16* Wg = poolw_t + g * 16384;
#pragma unroll 1
        for (int nt = 0; nt < 4; ++nt) {
            f32x16 acc0, acc1;
#pragma unroll
            for (int r = 0; r < 16; ++r) { acc0[r] = 0.f; acc1[r] = 0.f; }
#pragma unroll
            for (int ks = 0; ks < 8; ++ks) { const bf16x8 A = *(const bf16x8*)(Wg + (32 * nt + c) * 128 + 16 * ks + 8 * hf);
                acc0 = mfma32(A, Bf[0][ks], acc0); acc1 = mfma32(A, Bf[1][ks], acc1); }
#pragma unroll
            for (int q4 = 0; q4 < 4; ++q4) { const int n0 = 32 * nt + 8 * q4 + 4 * hf; const f32x4 sc = *(const f32x4*)(a.pool_scale + g * 128 + n0);
                u32x2 o0, o1; o0.x = pk2(acc0[4 * q4] * sc.x, acc0[4 * q4 + 1] * sc.y); o0.y = pk2(acc0[4 * q4 + 2] * sc.z, acc0[4 * q4 + 3] * sc.w);
                o1.x = pk2(acc1[4 * q4] * sc.x, acc1[4 * q4 + 1] * sc.y); o1.y = pk2(acc1[4 * q4 + 2] * sc.z, acc1[4 * q4 + 3] * sc.w);
                *(u32x2*)(MIX + (size_t)(tok0 + c) * DM + g * 128 + n0) = o0; *(u32x2*)(MIX + (size_t)(tok0 + 32 + c) * DM + g * 128 + n0) = o1; }
        }
        LDS_WAIT(); asm volatile("" ::: "memory");
    }
    __syncthreads();
}
__device__ __forceinline__ void phase3_mlstm_fast(const Args& a, LAS unsigned char* lds, int G) {
    const int tid = threadIdx.x, lane = tid & 63, wave = __builtin_amdgcn_readfirstlane(tid >> 6);
    if (wave < 2) { for (int tk = blockIdx.x * 2 + wave; tk < NB * NHEAD * 2 * 4; tk += 2 * G) mlstm_task(a, lds + ML_LDS0 + wave * ML_WAVE_LDS, tk, lane); }
}

__device__ __forceinline__ void phase4(const Args& a, int G) {
    const int tid = threadIdx.x, lane = tid & 63, wave = __builtin_amdgcn_readfirstlane(tid >> 6);
    const int gw = blockIdx.x * NWAVES + wave, NGW = G * NWAVES;
    const bf16* P = (const bf16*)(a.ws + WS_P); bf16* MIX = (bf16*)(a.ws + WS_MIX); const float* HF = (const float*)(a.ws + WS_HF); const float* HB = (const float*)(a.ws + WS_HB);
    const int c0 = lane * 8;
    float hn[8];
#pragma unroll
    for (int e = 0; e < 8; ++e) hn[e] = a.head_norm[c0 + e];
    for (int row = gw; row < ML; row += NGW) {
        const f32x4 f0 = *(const f32x4*)(HF + (size_t)row * 512 + c0), f1 = *(const f32x4*)(HF + (size_t)row * 512 + c0 + 4);
        const f32x4 b0 = *(const f32x4*)(HB + (size_t)row * 512 + c0), b1 = *(const f32x4*)(HB + (size_t)row * 512 + c0 + 4);
        const u32x4 ow = *(const u32x4*)(P + (size_t)row * NP + 1536 + c0);
        float h[8];
#pragma unroll
        for (int e = 0; e < 4; ++e) { h[e] = f0[e] + b0[e]; h[4 + e] = f1[e] + b1[e]; }
        float ss = 0.f;
#pragma unroll
        for (int e = 0; e < 8; ++e) ss += h[e] * h[e];
        ss += __shfl_xor(ss, 1); ss += __shfl_xor(ss, 2); ss += __shfl_xor(ss, 4); ss += __shfl_xor(ss, 8);
        const float r = rsqrtf(ss * (1.f / DV) + EPS);
        float o[8];
#pragma unroll
        for (int e = 0; e < 4; ++e) { o[2 * e] = bflo(ow[e]); o[2 * e + 1] = bfhi(ow[e]); }
        u32x4 w;
#pragma unroll
        for (int e = 0; e < 4; ++e) { const float y0 = h[2 * e] * r * hn[2 * e] / (1.f + __expf(-o[2 * e])), y1 = h[2 * e + 1] * r * hn[2 * e + 1] / (1.f + __expf(-o[2 * e + 1])); w[e] = pk2(y0, y1); }
        *(u32x4*)(MIX + (size_t)row * DM + 512 + c0) = w;
    }
}

template <bool FINAL> __device__ __forceinline__ void phase_rownorm(const Args& a, int G) {
    const int tid = threadIdx.x, lane = tid & 63, wave = __builtin_amdgcn_readfirstlane(tid >> 6);
    const int gw = blockIdx.x * NWAVES + wave, NGW = G * NWAVES;
    const float* mod = (const float*)(a.ws + WS_MOD); bf16* h2 = (bf16*)(a.ws + WS_HX);
    for (int row = gw; row < ML; row += NGW) {
        float* xr = a.out + (size_t)row * DM;
        f32x4 v[4]; float s = 0.f;
#pragma unroll
        for (int j = 0; j < 4; ++j) { v[j] = *(const f32x4*)(xr + 4 * lane + 256 * j); s += (v[j].x * v[j].x + v[j].y * v[j].y) + (v[j].z * v[j].z + v[j].w * v[j].w); }
        const float r = rsqrtf(wave_sum(s) * (1.f / DM) + EPS);
        if (FINAL) {
#pragma unroll
            for (int j = 0; j < 4; ++j) { const f32x4 nf = *(const f32x4*)(a.norm_f + 4 * lane + 256 * j); *(f32x4*)(xr + 4 * lane + 256 * j) = (v[j] * r) * nf; }
        } else {
            const int b = row / SEQ; const float* mp = mod + (size_t)b * NMOD;
#pragma unroll
            for (int j = 0; j < 4; ++j) { const int k = 4 * lane + 256 * j; const f32x4 n2 = *(const f32x4*)(a.norm2 + k), sh = *(const f32x4*)(mp + 3 * DM + k), sc = *(const f32x4*)(mp + 4 * DM + k);
                const f32x4 h = ((v[j] * r) * n2) * (sc + 1.0f) + sh; u32x2 w; w.x = pk2(h.x, h.y); w.y = pk2(h.z, h.w); *(u32x2*)(h2 + (size_t)row * DM + k) = w; }
        }
    }
}


typedef GAS unsigned gu32;
#define RLX_AGENT __ATOMIC_RELAXED, __HIP_MEMORY_SCOPE_AGENT
constexpr int MISC_OFF = RING_BYTES + 320;
constexpr size_t CTL_ZERO_BYTES = 16384;
#define XB_TMO      128
#define XB_XCNT(j)  (256  + 64 * (j))
#define XB_XSUB(j)  (1280 + 64 * (j))
#define XB_XGEN(j)  (2304 + 64 * (j))
#define XB_TOP      3328
#define XB_TOPGEN   3392
#define XCD_BAR_WORDS 3456
#define XB_SPIN_CAP (1u << 18)

__device__ __forceinline__ unsigned xb_ld(unsigned* p)              { return __hip_atomic_load(p, __ATOMIC_RELAXED, __HIP_MEMORY_SCOPE_AGENT); }
__device__ __forceinline__ unsigned xb_add(unsigned* p, unsigned v) { return __hip_atomic_fetch_add(p, v, __ATOMIC_RELAXED, __HIP_MEMORY_SCOPE_AGENT); }
__device__ __forceinline__ unsigned xb_xcc_id() { return (unsigned)__builtin_amdgcn_s_getreg((3 << 11) | 20) & 0xFu; }
#define XB_SPIN(cond, bar) do { unsigned _sp = 0; while (cond) { __builtin_amdgcn_s_sleep(1); \
    if ((++_sp & 255u) == 0u) { if (xb_ld(&(bar)[XB_TMO])) break; if (_sp > XB_SPIN_CAP) { atomicAdd(&(bar)[XB_TMO], 1u); break; } } } } while (0)

struct XcdBarrier {
    unsigned* bar; unsigned x;
    volatile LAS unsigned* st;
};

__device__ __forceinline__ XcdBarrier xcd_barrier_post(unsigned* bar, volatile LAS unsigned* st) {
    XcdBarrier b; b.bar = bar; b.x = xb_xcc_id(); b.st = st;
    if (threadIdx.x == 0) (void)xb_add(&bar[XB_XCNT(b.x)], 1u);
    return b;
}
__device__ __forceinline__ void xcd_barrier_complete(unsigned* bar, unsigned x, unsigned& nloc, unsigned& nx) {
    const unsigned G = gridDim.x * gridDim.y * gridDim.z;
    unsigned sum, cnt, mine, sp = 0u;
    for (;;) {
        sum = 0u; cnt = 0u; mine = 0u;
#pragma unroll
        for (unsigned j = 0; j < 16; ++j) { const unsigned c = xb_ld(&bar[XB_XCNT(j)]); sum += c; cnt += (c > 0u) ? 1u : 0u; mine = (j == x) ? c : mine; }
        if (sum == G) break;
        __builtin_amdgcn_s_sleep(1);
        if ((++sp & 255u) == 0u) { if (xb_ld(&bar[XB_TMO])) break; if (sp > XB_SPIN_CAP) { atomicAdd(&bar[XB_TMO], 1u); break; } }
    }
    nloc = mine > 0u ? mine : 1u; nx = cnt > 0u ? cnt : 1u;
}

__device__ __forceinline__ void xcd_barrier(const XcdBarrier& b) {
    asm volatile("s_waitcnt vmcnt(0)" ::: "memory");
    __syncthreads();
    if (threadIdx.x == 0) {
        unsigned* bar = b.bar;
        __builtin_amdgcn_s_waitcnt(0);
        unsigned nloc = b.st[0], nx = b.st[1];
        if (nloc == 0u) { xcd_barrier_complete(bar, b.x, nloc, nx); b.st[0] = nloc; b.st[1] = nx; }
        const unsigned old = xb_add(&bar[XB_XSUB(b.x)], 1u);
        const unsigned gen = old / nloc;
        if (old + 1u == (gen + 1u) * nloc) {
            __builtin_amdgcn_fence(__ATOMIC_RELEASE, "agent");
            asm volatile("s_waitcnt vmcnt(0)" ::: "memory");
            const unsigned og = xb_add(&bar[XB_TOP], 1u);
            const unsigned tg = og / nx;
            if (og + 1u == (tg + 1u) * nx) xb_add(&bar[XB_TOPGEN], 1u);
            else XB_SPIN(xb_ld(&bar[XB_TOPGEN]) == tg, bar);
            __builtin_amdgcn_fence(__ATOMIC_ACQUIRE, "agent");
            xb_add(&bar[XB_XGEN(b.x)], 1u);
            asm volatile("s_waitcnt vmcnt(0)" ::: "memory");
        } else {
            XB_SPIN(xb_ld(&bar[XB_XGEN(b.x)]) == gen, bar);
            __builtin_amdgcn_fence(__ATOMIC_ACQUIRE, "agent");
            asm volatile("s_waitcnt vmcnt(0)" ::: "memory");
        }
    }
    __syncthreads();
}

constexpr int N_PHASES = 11;
__global__ void __launch_bounds__(NTHR, 2) fwd_kernel(Args a) {
    extern __shared__ __attribute__((aligned(16))) unsigned char lds_raw[];
    LAS unsigned char* lds = (LAS unsigned char*)lds_raw;
    const int G = gridDim.x;
    const int lo = a.ph_lo, hi = a.ph_hi;
    for (int u = threadIdx.x; u < (LDS_BYTES - RING_BYTES) / 4; u += NTHR) ((LAS unsigned*)(lds + RING_BYTES))[u] = 0u;
    __syncthreads();
    XcdBarrier bar = xcd_barrier_post((unsigned*)(a.ws + WS_CTL), (volatile LAS unsigned*)(lds + MISC_OFF) + 8);
#ifndef PHASE_MASK
#define PHASE_MASK 0x7ff
#endif
#define IN(k) ((((PHASE_MASK) >> (k)) & 1) && lo <= (k) && (k) < hi)
#ifndef DUP_MASK
#define DUP_MASK 0
#endif
#define REP(k) for (int rep_ = 0; rep_ < 1 + (((DUP_MASK) >> (k)) & 1); ++rep_)
#define SEAM(k) do { if (IN(k) && IN((k) + 1)) xcd_barrier(bar); } while (0)
    unsigned char* ws = a.ws;
    if (IN(0)) REP(0) { phase0(a, lds, G); } SEAM(0);
    if (IN(1)) REP(1) { phase1(a, lds, G); } SEAM(1);
    if (IN(2)) REP(2) {
        pg8::Gemm g{(const bf16*)(ws + WS_HX), (const bf16*)(ws + WS_WIN), MT, NP, DM}; pg8::StaticOrder S; S.init(MT, NP, G, (int)blockIdx.x);
        pg8::EpiBf16Plain E{(bf16*)(ws + WS_P), NP};
        pg8::gemm_phase<pg8::EpiBf16Plain, pg8::StaticOrder, true, true>(lds, g, S, E);
    } SEAM(2);
    if (IN(3)) REP(3) { phase2b(a, G); } SEAM(3);
    if (IN(4)) { REP(11) { phase3_pool_fast(a, lds, G); } REP(4) { phase3_mlstm_fast(a, lds, G); } } SEAM(4);
    if (IN(5)) REP(5) { phase4(a, G); } SEAM(5);
    if (IN(6)) REP(6) {
        pg8::Gemm g{(const bf16*)(ws + WS_MIX), (const bf16*)(ws + WS_WOUT), ML, DM, DM}; pg8::StaticOrder S; S.init(ML, DM, G, (int)blockIdx.x);
        pg8::EpiResGate E{a.x, a.out, DM, (const float*)(ws + WS_MOD) + 2 * DM, NMOD, SEQ / 256};
        pg8::gemm_phase<pg8::EpiResGate, pg8::StaticOrder, true, true>(lds, g, S, E);
    } SEAM(6);
    if (IN(7)) REP(7) { phase_rownorm<false>(a, G); } SEAM(7);
    if (IN(8)) REP(8) {
        pg8::Gemm g{(const bf16*)(ws + WS_HX), (const bf16*)(ws + WS_WUP), ML, 2 * DFF, DM}; pg8::StaticOrder S; S.init(ML, 2 * DFF, G, (int)blockIdx.x);
        pg8::EpiSwiglu E{(bf16*)(ws + WS_HID), DFF};
        pg8::gemm_phase<pg8::EpiSwiglu, pg8::StaticOrder, true, true>(lds, g, S, E);
    } SEAM(8);
    if (IN(9)) REP(9) {
        pg8::Gemm g{(const bf16*)(ws + WS_HID), (const bf16*)(ws + WS_WDN), ML, DM, DFF}; pg8::StaticOrder S; S.init(ML, DM, G, (int)blockIdx.x);
        pg8::EpiResGate E{a.out, a.out, DM, (const float*)(ws + WS_MOD) + 5 * DM, NMOD, SEQ / 256};
        pg8::gemm_phase<pg8::EpiResGate, pg8::StaticOrder, true, true>(lds, g, S, E);
    } SEAM(9);
    if (IN(10)) REP(10) { phase_rownorm<true>(a, G); }
#undef IN
#undef SEAM
}

#ifndef N_LAUNCHES
#define N_LAUNCHES 1
#endif
extern "C" void kernel_launch(void* const* d_in, const int* in_sizes, int n_in, void* d_out, int out_size, void* d_ws, size_t ws_size, hipStream_t stream) {
    static int grid = 0;
    if (grid == 0) {
        if (n_in != 18 || out_size != ML * DM || ws_size < WS_END) { fprintf(stderr, "kernel_launch: unexpected shapes (n_in %d out %d ws %zu)\n", n_in, out_size, ws_size); grid = -1; return; }
        int dev = 0, cus = 0, per_cu = 0;
        hipGetDevice(&dev); hipDeviceGetAttribute(&cus, hipDeviceAttributeMultiprocessorCount, dev);
        if (hipFuncSetAttribute((const void*)fwd_kernel, hipFuncAttributeMaxDynamicSharedMemorySize, LDS_BYTES) != hipSuccess) { fprintf(stderr, "kernel_launch: hipFuncSetAttribute failed\n"); grid = -1; return; }
        if (hipOccupancyMaxActiveBlocksPerMultiprocessor(&per_cu, (const void*)fwd_kernel, NTHR, LDS_BYTES) != hipSuccess || per_cu < 1) { fprintf(stderr, "kernel_launch: occupancy query says %d\n", per_cu); per_cu = 1; }
        (void)hipGetLastError();
        grid = cus * (per_cu > 1 ? 1 : per_cu);
        if (grid <= 0) grid = 256;
    }
    if (grid < 0) return;
    Args a{};
    a.x = (const float*)d_in[0]; a.c = (const float*)d_in[1]; a.ctx = (const float*)d_in[2]; a.c_ctx = (const float*)d_in[3]; a.w_ada = (const float*)d_in[4]; a.b_ada = (const float*)d_in[5];
    a.norm1 = (const float*)d_in[6]; a.w_in = (const float*)d_in[7]; a.conv_qk = (const float*)d_in[8]; a.gate_bias = (const float*)d_in[9]; a.pool_w = (const float*)d_in[10]; a.pool_scale = (const float*)d_in[11];
    a.head_norm = (const float*)d_in[12]; a.w_out = (const float*)d_in[13]; a.norm2 = (const float*)d_in[14]; a.w_up = (const float*)d_in[15]; a.w_down = (const float*)d_in[16]; a.norm_f = (const float*)d_in[17];
    a.out = (float*)d_out; a.ws = (unsigned char*)d_ws;
    if (hipMemsetAsync((char*)d_ws + WS_CTL, 0, CTL_ZERO_BYTES, stream) != hipSuccess) { fprintf(stderr, "kernel_launch: memset failed\n"); return; }
#if N_LAUNCHES == 1
    a.ph_lo = 0; a.ph_hi = N_PHASES;
    void* args[] = {&a};
    hipError_t e = hipLaunchCooperativeKernel((const void*)fwd_kernel, dim3(grid), dim3(NTHR), args, LDS_BYTES, stream);
    if (e != hipSuccess) fprintf(stderr, "cooperative launch failed: %s (grid %d)\n", hipGetErrorString(e), grid);
#else
    for (int p = 0; p < N_PHASES; ++p) { a.ph_lo = p; a.ph_hi = p + 1; hipLaunchKernelGGL(fwd_kernel, dim3(grid), dim3(NTHR), LDS_BYTES, stream, a); }
#endif
}
```
